# Optimizing an MI355X kernel written in HIP

```python
import math
import jax, jax.numpy as jnp
from jax import lax
import numpy as np

D_MODEL = 1024
BATCH = 8
SEQ = 2048
DEPTH = 2

MIX_W = D_MODEL // 2
N_BRANCH = 3
HG_KEY = 128
HG_HEADS = MIX_W // HG_KEY
HG_VAL = MIX_W // HG_HEADS
HG_CHUNK = 64
FOX_HEAD_DIM = 64
FOX_HEADS = MIX_W // FOX_HEAD_DIM
FOX_BLOCK = 128
S5_GROUP_CH = 16
S5_GROUPS = MIX_W // S5_GROUP_CH
S5_STATE = 64
S5_DT_MIN = 1e-3
S5_DT_MAX = 1e-1
FFN_HIDDEN = -(-8 * D_MODEL // (3 * 256)) * 256
DEEPNORM_ALPHA = (2 * DEPTH) ** 0.25
DEEPNORM_BETA = (8 * DEPTH) ** -0.25
LN_EPS = 1e-5
RMS_EPS = 1e-6
IN_WIDTHS = (HG_HEADS * HG_KEY, HG_HEADS * HG_KEY, MIX_W, MIX_W,
             MIX_W, MIX_W, MIX_W, FOX_HEADS,
             MIX_W,
             N_BRANCH * D_MODEL)
IN_TOTAL = sum(IN_WIDTHS)

kernel_name = 'hybrid_hgrn2_fox_s5_deepnorm'


def _split_points():
    return [int(v) for v in np.cumsum(IN_WIDTHS)[:-1]]


def layer_norm(x, g, b):
    xf = x.astype(jnp.float32)
    mu = jnp.mean(xf, axis=-1, keepdims=True)
    var = jnp.mean(jnp.square(xf - mu), axis=-1, keepdims=True)
    return ((xf - mu) * lax.rsqrt(var + LN_EPS) * g + b).astype(x.dtype)


def hgrn2_branch(q, f_logit, i, gate, lb, norm_w):
    f32 = jnp.float32
    bsz, seq_len, _ = q.shape
    n_chunks = seq_len // HG_CHUNK
    f = lb + (1.0 - lb) * jax.nn.sigmoid(f_logit.astype(f32))
    k = 1.0 - f

    def chunks(t, width):
        t = t.astype(f32).reshape(bsz, n_chunks, HG_CHUNK, HG_HEADS, width)
        return t.transpose(1, 0, 3, 2, 4)

    qc = chunks(q, HG_KEY)
    kc = chunks(k, HG_KEY)
    vc = chunks(i, HG_VAL)
    gc = jnp.cumsum(chunks(jnp.log(f), HG_KEY), axis=3)
    causal = jnp.tril(jnp.ones((HG_CHUNK, HG_CHUNK), dtype=bool))[:, :, None]

    def step(state, xs):
        qb, kb, vb, gb = xs
        g_last = gb[:, :, -1, :]
        o_inter = jnp.einsum('bhtk,bhkv->bhtv', qb * jnp.exp(gb), state)
        rel = gb[:, :, :, None, :] - gb[:, :, None, :, :]
        decay = jnp.exp(jnp.where(causal, rel, -jnp.inf))
        scores = jnp.einsum('bhtsk,bhsk->bhts', qb[:, :, :, None, :] * decay, kb)
        o_intra = jnp.einsum('bhts,bhsv->bhtv', scores, vb)
        k_to_end = kb * jnp.exp(g_last[:, :, None, :] - gb)
        new_state = (jnp.exp(g_last)[..., None] * state
                     + jnp.einsum('bhsk,bhsv->bhkv', k_to_end, vb))
        return new_state, o_inter + o_intra

    state0 = jnp.zeros((bsz, HG_HEADS, HG_KEY, HG_VAL), f32)
    _, o = lax.scan(step, state0, (qc, kc, vc, gc))
    o = o.transpose(1, 0, 3, 2, 4).reshape(bsz, seq_len, HG_HEADS, HG_VAL)
    o = o * lax.rsqrt(jnp.mean(jnp.square(o), axis=-1, keepdims=True) + RMS_EPS) * norm_w.astype(f32)
    g = gate.astype(f32).reshape(bsz, seq_len, HG_HEADS, HG_VAL)
    return (o * jax.nn.silu(g)).reshape(bsz, seq_len, MIX_W)


def fox_branch(q, k, v, f_logit):
    f32 = jnp.float32
    bsz, seq_len, _ = q.shape
    shp = (bsz, seq_len, FOX_HEADS, FOX_HEAD_DIM)
    q = q.reshape(shp)
    k = k.reshape(shp)
    v = v.reshape(shp)
    cum = jnp.cumsum(jax.nn.log_sigmoid(f_logit.astype(f32)), axis=1).transpose(0, 2, 1)
    scale = FOX_HEAD_DIM ** -0.5
    outs = []
    for blk in range(seq_len // FOX_BLOCK):
        t0 = blk * FOX_BLOCK
        t1 = t0 + FOX_BLOCK
        logits = jnp.einsum('bthd,bshd->bhts', q[:, t0:t1], k[:, :t1]).astype(f32) * scale
        logits = logits + cum[:, :, t0:t1, None] - cum[:, :, None, :t1]
        mask = (t0 + jnp.arange(FOX_BLOCK))[:, None] >= jnp.arange(t1)[None, :]
        probs = jax.nn.softmax(jnp.where(mask, logits, -jnp.inf), axis=-1)
        outs.append(jnp.einsum('bhts,bshd->bthd', probs.astype(v.dtype), v[:, :t1]))
    return jnp.concatenate(outs, axis=1).reshape(bsz, seq_len, MIX_W)


def s5_branch(u, lam_re, lam_im, log_step, b_re, b_im, c_re, c_im, d, w_glu):
    f32 = jnp.float32
    bsz, seq_len, _ = u.shape
    uc = u.astype(f32).reshape(bsz, seq_len, S5_GROUPS, S5_GROUP_CH)
    lam = lax.complex(lam_re.astype(f32), lam_im.astype(f32))
    dt = jnp.exp(log_step.astype(f32))[:, None]
    lam_bar = jnp.exp(lam * dt)
    b_bar = ((lam_bar - 1.0) / lam)[:, :, None] * lax.complex(b_re.astype(f32), b_im.astype(f32))
    c_mat = lax.complex(c_re.astype(f32), c_im.astype(f32))
    bu = jnp.einsum('gph,blgh->lbgp', b_bar, uc.astype(jnp.complex64))
    a = jnp.broadcast_to(lam_bar, (seq_len, 1, S5_GROUPS, S5_STATE))

    def combine(e1, e2):
        a1, s1 = e1
        a2, s2 = e2
        return a1 * a2, a2 * s1 + s2

    _, states = lax.associative_scan(combine, (a, bu), axis=0)
    y = jnp.einsum('ghp,lbgp->blgh', c_mat, states).real + d.astype(f32) * uc
    y = jax.nn.gelu(y.reshape(bsz, seq_len, MIX_W))
    return y * jax.nn.sigmoid(y @ w_glu.astype(f32))


def mixer_sublayer(h, w_in, lb, hg_norm_w, fox_b_f, lam_re, lam_im, log_step, b_re, b_im,
                   c_re, c_im, s5_d, s5_w_glu, w_br_a, w_br_b, w_br_c, w_out):
    dt = h.dtype
    bsz, seq_len, _ = h.shape
    proj = jnp.einsum('bld,de->ble', h, w_in)
    (hg_q, hg_f, hg_i, hg_g, fx_q, fx_k, fx_v, fx_f, s5_u, gate_logits) = jnp.split(
        proj, _split_points(), axis=-1)
    y_a = hgrn2_branch(hg_q, hg_f, hg_i, hg_g, lb, hg_norm_w).astype(dt)
    y_b = fox_branch(fx_q, fx_k, fx_v, fx_f + fox_b_f).astype(dt)
    y_c = s5_branch(s5_u, lam_re, lam_im, log_step, b_re, b_im, c_re, c_im, s5_d, s5_w_glu).astype(dt)
    gates = jax.nn.sigmoid(gate_logits.astype(jnp.float32)).astype(dt).reshape(
        bsz, seq_len, N_BRANCH, D_MODEL)
    merged = (gates[:, :, 0] * (y_a @ w_br_a)
              + gates[:, :, 1] * (y_b @ w_br_b)
              + gates[:, :, 2] * (y_c @ w_br_c))
    return merged @ w_out


def swiglu_ffn(h, w_gate, w_up, w_down):
    return (jax.nn.silu(h @ w_gate) * (h @ w_up)) @ w_down


def _normal(k, shape, scale):
    return jax.random.normal(k, shape, jnp.float32) * scale


def setup_inputs(seed: int = 0) -> dict:
    key = jax.random.key(seed)
    ks = jax.random.split(key, 25)
    G, P, Hc = S5_GROUPS, S5_STATE, S5_GROUP_CH
    return {
        'x': _normal(ks[0], (BATCH, SEQ, D_MODEL), 1.0),
        'w_in': _normal(ks[1], (DEPTH, D_MODEL, IN_TOTAL), D_MODEL ** -0.5),
        'hg_lower_bounds': _normal(ks[2], (DEPTH, HG_HEADS * HG_KEY), 0.1),
        'hg_norm_w': 1.0 + _normal(ks[3], (DEPTH, HG_VAL), 0.02),
        'fox_b_f': _normal(ks[4], (DEPTH, FOX_HEADS), 0.1),
        's5_lambda_re': -0.5 + _normal(ks[5], (DEPTH, G, P), 0.01),
        's5_lambda_im': jnp.pi * jnp.arange(P, dtype=jnp.float32) + _normal(ks[6], (DEPTH, G, P), 0.01),
        's5_log_step': jax.random.uniform(ks[7], (DEPTH, G), jnp.float32,
                                          math.log(S5_DT_MIN), math.log(S5_DT_MAX)),
        's5_b_re': _normal(ks[8], (DEPTH, G, P, Hc), (2.0 * Hc) ** -0.5),
        's5_b_im': _normal(ks[9], (DEPTH, G, P, Hc), (2.0 * Hc) ** -0.5),
        's5_c_re': _normal(ks[10], (DEPTH, G, Hc, P), P ** -0.5),
        's5_c_im': _normal(ks[11], (DEPTH, G, Hc, P), P ** -0.5),
        's5_d': _normal(ks[12], (DEPTH, G, Hc), 1.0),
        's5_w_glu': _normal(ks[13], (DEPTH, MIX_W, MIX_W), MIX_W ** -0.5),
        'w_br_a': _normal(ks[14], (DEPTH, MIX_W, D_MODEL), MIX_W ** -0.5),
        'w_br_b': _normal(ks[15], (DEPTH, MIX_W, D_MODEL), MIX_W ** -0.5),
        'w_br_c': _normal(ks[16], (DEPTH, MIX_W, D_MODEL), MIX_W ** -0.5),
        'w_out': _normal(ks[17], (DEPTH, D_MODEL, D_MODEL), D_MODEL ** -0.5 * DEEPNORM_BETA),
        'ln1_g': 1.0 + _normal(ks[18], (DEPTH, D_MODEL), 0.02),
        'ln1_b': _normal(ks[19], (DEPTH, D_MODEL), 0.02),
        'w_ffn_gate': _normal(ks[20], (DEPTH, D_MODEL, FFN_HIDDEN), D_MODEL ** -0.5),
        'w_ffn_up': _normal(ks[21], (DEPTH, D_MODEL, FFN_HIDDEN), D_MODEL ** -0.5),
        'w_ffn_down': _normal(ks[22], (DEPTH, FFN_HIDDEN, D_MODEL), FFN_HIDDEN ** -0.5 * DEEPNORM_BETA),
        'ln2_g': 1.0 + _normal(ks[23], (DEPTH, D_MODEL), 0.02),
        'ln2_b': _normal(ks[24], (DEPTH, D_MODEL), 0.02),
    }


def reference(x, w_in, hg_lower_bounds, hg_norm_w, fox_b_f, s5_lambda_re, s5_lambda_im, s5_log_step,
              s5_b_re, s5_b_im, s5_c_re, s5_c_im, s5_d, s5_w_glu, w_br_a, w_br_b, w_br_c, w_out,
              ln1_g, ln1_b, w_ffn_gate, w_ffn_up, w_ffn_down, ln2_g, ln2_b):
    sm = jax.nn.softmax(hg_lower_bounds.astype(jnp.float32), axis=0)
    lower_bounds = jnp.cumsum(sm, axis=0) - sm[0:1]
    h = x
    for l in range(DEPTH):
        mix = mixer_sublayer(h, w_in[l], lower_bounds[l], hg_norm_w[l], fox_b_f[l],
                             s5_lambda_re[l], s5_lambda_im[l], s5_log_step[l], s5_b_re[l], s5_b_im[l],
                             s5_c_re[l], s5_c_im[l], s5_d[l], s5_w_glu[l],
                             w_br_a[l], w_br_b[l], w_br_c[l], w_out[l])
        h = layer_norm(DEEPNORM_ALPHA * h + mix, ln1_g[l], ln1_b[l])
        ffn = swiglu_ffn(h, w_ffn_gate[l], w_ffn_up[l], w_ffn_down[l])
        h = layer_norm(DEEPNORM_ALPHA * h + ffn, ln2_g[l], ln2_b[l])
    return h
```

```cpp
#include <hip/hip_runtime.h>
#include <hip/hip_cooperative_groups.h>
#include <cstdio>
#include <cstdint>
namespace cg = cooperative_groups;
namespace pg8 {
#define PG8_LAS __attribute__((address_space(3)))
typedef unsigned short bf16_t;
typedef short bf16x8 __attribute__((ext_vector_type(8)));
typedef float f32x4 __attribute__((ext_vector_type(4)));
typedef unsigned u32x4 __attribute__((ext_vector_type(4)));
constexpr int BM = 256, BK = 64, HALF = 128, HTB = HALF * BK * 2  , STAGE_BYTES = 8 * HTB, NXCD = 8, WGM = 8;

__host__ __device__ __forceinline__ int lds_byte(int r, int c) { const int st = (r >> 4) * 2 + (c >> 5), rr = r & 15, cc = c & 31, ob = rr * 64 + cc * 2; return st * 1024 + (ob ^ (((ob >> 9) & 1) << 5)); }
__host__ __device__ __forceinline__ void stage_rc(int b, int& R, int& C) { const int st = b / 1024, sb = b % 1024, swz = sb ^ (((sb >> 9) & 1) << 5); R = (st >> 1) * 16 + swz / 64; C = (st & 1) * 32 + (swz % 64) / 2; }
__host__ __device__ __forceinline__ int perm32(int rho) { const int n = rho >> 4, i = rho & 15; return 8 * (i >> 2) + 4 * n + (i & 3); }

struct Unit { int pm, pn; };
struct Gemm { const bf16_t* A; const bf16_t* Bt; int M, N, K; };

struct StaticOrder {
    int nM, nN, nwg, G, c;
    __host__ __device__ void init(int M, int N, int G_, int c_) { nM = M / BM; nN = N / BM; nwg = nM * nN; G = G_; c = c_; }
    __host__ __device__ bool next(int i, Unit& u) const {
        const long L = (long)i * G + c; if (L >= nwg) return false;
        int wgid = (int)L; { const int q = nwg / NXCD, r = nwg % NXCD, xcd = wgid % NXCD, off = wgid / NXCD; wgid = (xcd < r ? xcd * (q + 1) : r * (q + 1) + (xcd - r) * q) + off; }
        const int nig = WGM * nN, gid = wgid / nig, fm = gid * WGM, gsz = (nM - fm) < WGM ? (nM - fm) : WGM;
        u.pm = fm + ((wgid % nig) % gsz); u.pn = (wgid % nig) / gsz; return true;
    }
    __device__ __forceinline__ void a_ready(const Unit&) const {}
    __device__ __forceinline__ void done(const Unit&) const {}
};

__device__ __forceinline__ unsigned cvt_pk_bf16(float lo, float hi) { unsigned r; asm volatile("v_cvt_pk_bf16_f32 %0, %1, %2" : "=v"(r) : "v"(lo), "v"(hi)); return r; }
typedef float f32x2 __attribute__((ext_vector_type(2)));

template <class Epi, class Sched, bool ALIGN_EPI = false, bool SP2 = false>
__device__ __forceinline__ void gemm_phase(PG8_LAS unsigned char* lds, const Gemm g, const Sched& S, const Epi& E) {
    int tid_o = threadIdx.x; asm volatile("" : "+v"(tid_o));
    const int tid = tid_o, wid = __builtin_amdgcn_readfirstlane(tid >> 6), lane = tid & 63, wr = wid >> 2, wc = wid & 3, fr = lane & 15, fq = lane >> 4;
    const int K = g.K, nt = K / BK;
    unsigned voffA[2], voffB[2];
#pragma unroll
    for (int i = 0; i < 2; ++i) { int R, C; stage_rc(tid * 16 + i * 8192, R, C); const int Rb = Epi::PERM ? ((R & ~31) + perm32(R & 31)) : R;
        voffA[i] = (unsigned)(R * K + C) * 2u; voffB[i] = (unsigned)(Rb * K + C) * 2u; }
    const size_t kstep = (size_t)(BK * 2);
    const size_t hstep = (size_t)HALF * K * 2;
    const size_t tstep = 2 * hstep;
    const unsigned ldsw = (unsigned)wid * 1024u;
    const int aoff = lds_byte(wr * 64 + fr, fq * 8), boff = lds_byte(wc * 32 + fr, fq * 8);
#define PG8_SA(b, h) (((b) * 2 + (h)) * HTB)
#define PG8_SB(b, h) ((4 + (b) * 2 + (h)) * HTB)
#define PG8_STAGE(bufoff, gbase, voff) do { _Pragma("unroll") for (int _i = 0; _i < 2; ++_i) \
        __builtin_amdgcn_global_load_lds((const unsigned*)((const char*)(gbase) + (voff)[_i]), (PG8_LAS unsigned*)(lds + (bufoff) + ldsw + _i * 8192), 16, 0, 0); } while (0)
#define PG8_LDA(dst, b, h) do { _Pragma("unroll") for (int m = 0; m < 4; ++m) _Pragma("unroll") for (int k = 0; k < 2; ++k) dst[m][k] = *(const PG8_LAS bf16x8*)(lds + PG8_SA(b, h) + aoff + m * 2048 + k * 1024); } while (0)
#define PG8_LDB(dst, b, h) do { _Pragma("unroll") for (int n = 0; n < 2; ++n) _Pragma("unroll") for (int k = 0; k < 2; ++k) dst[n][k] = *(const PG8_LAS bf16x8*)(lds + PG8_SB(b, h) + boff + n * 2048 + k * 1024); } while (0)
#define PG8_MMA(ai, bj, At, Bt) do { __builtin_amdgcn_s_setprio(1); _Pragma("unroll") for (int m = 0; m < 4; ++m) _Pragma("unroll") for (int n = 0; n < 2; ++n) _Pragma("unroll") for (int k = 0; k < 2; ++k) \
        acc[ai][bj][m][n] = __builtin_amdgcn_mfma_f32_16x16x32_bf16(Bt[n][k], At[m][k], acc[ai][bj][m][n], 0, 0, 0); __builtin_amdgcn_s_setprio(0); } while (0)
#define PG8_WAIT_V(n) asm volatile("s_waitcnt vmcnt(" #n ")" ::: "memory")
#define PG8_WAIT_L(n) asm volatile("s_waitcnt lgkmcnt(" #n ")" ::: "memory")
#define PG8_BAR __builtin_amdgcn_s_barrier()
#define PG8_SCHED __builtin_amdgcn_sched_barrier(0)
    Unit cur, nxt; int ui = 0;
    if (!S.next(0, cur)) return;
    f32x4 acc[2][2][4][2];
#pragma unroll
    for (int a = 0; a < 2; ++a)
#pragma unroll
        for (int b = 0; b < 2; ++b)
#pragma unroll
            for (int m = 0; m < 4; ++m)
#pragma unroll
                for (int n = 0; n < 2; ++n) acc[a][b][m][n] = (f32x4){0.f, 0.f, 0.f, 0.f};
    bf16x8 At[4][2], B0[2][2], B1[2][2];
    const char* cA = (const char*)g.A + (size_t)cur.pm * tstep; const char* cB = (const char*)g.Bt + (size_t)cur.pn * tstep;
    S.a_ready(cur);
    if constexpr (SP2) {
        PG8_STAGE(PG8_SB(0, 0), cB, voffB); PG8_STAGE(PG8_SB(0, 1), cB + hstep, voffB); PG8_STAGE(PG8_SA(0, 0), cA, voffA); PG8_STAGE(PG8_SA(0, 1), cA + hstep, voffA);
        if (wr == 1) PG8_BAR;
        PG8_WAIT_V(2); PG8_BAR;
        PG8_STAGE(PG8_SB(1, 0), cB + kstep, voffB); PG8_STAGE(PG8_SA(1, 0), cA + kstep, voffA); PG8_STAGE(PG8_SB(1, 1), cB + hstep + kstep, voffB);
        PG8_WAIT_V(6); PG8_BAR;
    } else {
        PG8_STAGE(PG8_SB(0, 0), cB, voffB); PG8_STAGE(PG8_SA(0, 0), cA, voffA); PG8_STAGE(PG8_SB(0, 1), cB + hstep, voffB); PG8_STAGE(PG8_SA(0, 1), cA + hstep, voffA);
        if (wr == 1) PG8_BAR;
        PG8_WAIT_V(4); PG8_BAR;
        PG8_STAGE(PG8_SB(1, 0), cB + kstep, voffB); PG8_STAGE(PG8_SA(1, 0), cA + kstep, voffA); PG8_STAGE(PG8_SB(1, 1), cB + hstep + kstep, voffB);
        PG8_WAIT_V(6); PG8_BAR;
    }
    for (;;) {
        const bool has_next = S.next(ui + 1, nxt);
        const char* nA = has_next ? (const char*)g.A + (size_t)nxt.pm * tstep : cA; const char* nB = has_next ? (const char*)g.Bt + (size_t)nxt.pn * tstep : cB;
        for (int t = 0; t < nt; t += 2) {
            const bool last = (t == nt - 2);
            const char* a1 = cA + (size_t)(t + 1) * kstep;
            const char* a2 = last ? nA : cA + (size_t)(t + 2) * kstep; const char* b2 = last ? nB : cB + (size_t)(t + 2) * kstep;
            const char* a3 = a2 + kstep; const char* b3 = b2 + kstep;
            if (last && has_next) S.a_ready(nxt);
            if constexpr (SP2) {
            PG8_LDB(B0, 0, 0); PG8_LDB(B1, 0, 1); PG8_SCHED; PG8_LDA(At, 0, 0); PG8_STAGE(PG8_SA(1, 1), a1 + hstep, voffA);
            PG8_WAIT_V(8); PG8_WAIT_L(0); PG8_BAR; PG8_MMA(0, 0, At, B0); PG8_MMA(0, 1, At, B1); PG8_BAR; PG8_SCHED;
            PG8_LDA(At, 0, 1); PG8_STAGE(PG8_SB(0, 0), b2, voffB); PG8_STAGE(PG8_SB(0, 1), b2 + hstep, voffB); PG8_STAGE(PG8_SA(0, 0), a2, voffA);
            PG8_WAIT_V(8); PG8_WAIT_L(0); PG8_BAR; PG8_MMA(1, 0, At, B0); PG8_MMA(1, 1, At, B1); PG8_BAR; PG8_SCHED;
            PG8_LDB(B0, 1, 0); PG8_LDB(B1, 1, 1); PG8_SCHED; PG8_LDA(At, 1, 0); PG8_STAGE(PG8_SA(0, 1), a2 + hstep, voffA);
            PG8_WAIT_V(8); PG8_WAIT_L(0); PG8_BAR; PG8_MMA(0, 0, At, B0); PG8_MMA(0, 1, At, B1); PG8_BAR; PG8_SCHED;
            PG8_LDA(At, 1, 1); PG8_STAGE(PG8_SB(1, 0), b3, voffB); PG8_STAGE(PG8_SB(1, 1), b3 + hstep, voffB); PG8_STAGE(PG8_SA(1, 0), a3, voffA);
            PG8_WAIT_V(8); PG8_WAIT_L(0); PG8_BAR; PG8_MMA(1, 0, At, B0); PG8_MMA(1, 1, At, B1); PG8_BAR; PG8_SCHED;
            } else {
            PG8_LDB(B0, 0, 0); PG8_SCHED; PG8_LDA(At, 0, 0); PG8_STAGE(PG8_SA(1, 1), a1 + hstep, voffA);
            PG8_WAIT_L(8); PG8_BAR; PG8_WAIT_L(0); PG8_MMA(0, 0, At, B0); PG8_BAR; PG8_SCHED;
            PG8_LDB(B1, 0, 1); PG8_STAGE(PG8_SB(0, 0), b2, voffB);
            PG8_BAR; PG8_WAIT_L(0); PG8_MMA(0, 1, At, B1); PG8_BAR;
            PG8_LDA(At, 0, 1); PG8_STAGE(PG8_SA(0, 0), a2, voffA);
            PG8_BAR; PG8_WAIT_L(0); PG8_MMA(1, 0, At, B0); PG8_BAR; PG8_SCHED;
            PG8_STAGE(PG8_SB(0, 1), b2 + hstep, voffB);
            PG8_WAIT_V(6); PG8_BAR; PG8_MMA(1, 1, At, B1); PG8_BAR;
            PG8_LDB(B0, 1, 0); PG8_SCHED; PG8_LDA(At, 1, 0); PG8_STAGE(PG8_SA(0, 1), a2 + hstep, voffA);
            PG8_WAIT_L(8); PG8_BAR; PG8_WAIT_L(0); PG8_MMA(0, 0, At, B0); PG8_BAR; PG8_SCHED;
            PG8_LDB(B1, 1, 1); PG8_STAGE(PG8_SB(1, 0), b3, voffB);
            PG8_BAR; PG8_WAIT_L(0); PG8_MMA(0, 1, At, B1); PG8_BAR;
            PG8_LDA(At, 1, 1); PG8_STAGE(PG8_SA(1, 0), a3, voffA);
            PG8_BAR; PG8_WAIT_L(0); PG8_MMA(1, 0, At, B0); PG8_BAR; PG8_SCHED;
            PG8_STAGE(PG8_SB(1, 1), b3 + hstep, voffB);
            PG8_WAIT_V(6); PG8_BAR; PG8_MMA(1, 1, At, B1); PG8_BAR;
            }
        }
        if constexpr (ALIGN_EPI) { if (wr == 0) PG8_BAR; }
        if constexpr (!Epi::AFTER_DRAIN) { E(acc, cur, wr, wc, fr, fq); S.done(cur); }
        if (!has_next) break;
        if constexpr (!Epi::KEEP_ACC) {
#pragma unroll
        for (int a = 0; a < 2; ++a)
#pragma unroll
            for (int b = 0; b < 2; ++b)
#pragma unroll
                for (int m = 0; m < 4; ++m)
#pragma unroll
                    for (int n = 0; n < 2; ++n) acc[a][b][m][n] = (f32x4){0.f, 0.f, 0.f, 0.f};
        }
        cur = nxt; cA = nA; cB = nB; ++ui;
        if constexpr (ALIGN_EPI) { if (wr == 1) PG8_BAR; }
    }
    PG8_WAIT_V(0);
    if constexpr (!ALIGN_EPI) { if (wr == 0) PG8_BAR; }
    PG8_BAR;
    if constexpr (Epi::AFTER_DRAIN) { E.fused(acc, cur, wr, wc, fr, fq, lds, wid, lane); S.done(cur); }
#undef PG8_SA
#undef PG8_SB
#undef PG8_STAGE
#undef PG8_LDA
#undef PG8_LDB
#undef PG8_MMA
#undef PG8_WAIT_V
#undef PG8_WAIT_L
#undef PG8_BAR
#undef PG8_SCHED
}
}
#include <hip/hip_bf16.h>
#include <cmath>
namespace attn_body {
using bf16=__hip_bfloat16;
using bf16x8=__attribute__((ext_vector_type(8)))short;
using s16x4=__attribute__((ext_vector_type(4)))short;
using f32x16=__attribute__((ext_vector_type(16)))float;
using u32x4=__attribute__((ext_vector_type(4)))unsigned;
using f32x4b=__attribute__((ext_vector_type(4)))float;
constexpr int BATCH=8,NHEAD=8,SEQ=2048,D=64,DM=NHEAD*D;
constexpr int NW=8,QBLK=32,QB=QBLK*NW,KVBLK=64,NQB=SEQ/QB;
constexpr int ATTN_PITCH=DM, ATTN_UNIT_ROWS=QB;
__device__ __forceinline__ int crow(int r,int hi){return (r&3)+8*(r>>2)+4*hi;}
#define SBAR() __builtin_amdgcn_sched_barrier(0)
__device__ __forceinline__ void cmask(f32x16&p0,f32x16&p1,int jb,int qrel,int hi){
  const float NEG=-INFINITY; int kb=64*jb+4*hi;
  #pragma unroll
  for(int r=0;r<16;++r){int kv=kb+(r&3)+8*(r>>2); if(kv>qrel)p0[r]=NEG; if(kv+32>qrel)p1[r]=NEG;}
}

constexpr int NSLOT=3, SLOTB=8192;
constexpr int LDS_K=0, LDS_V=NSLOT*SLOTB, LDS_WS=2*NSLOT*SLOTB, LDS_OST=LDS_WS+NW*64*4, LDS_BIAS=LDS_OST+NW*4096, LDS_SCAN=LDS_BIAS+SEQ*4, LDS_BYTES=LDS_SCAN+256;
constexpr float C2=0.125f*1.4426950408889634f;
__device__ __forceinline__ void glds16(const void*gsrc,unsigned lds_dst){unsigned keep;
  asm volatile("s_mov_b32 %0, m0\n\ts_mov_b32 m0, %2\n\ts_nop 0\n\tglobal_load_lds_dwordx4 %1, off\n\ts_mov_b32 m0, %0":"=&s"(keep):"v"(gsrc),"s"(lds_dst):"memory");}
__device__ __forceinline__ float max3f(float a,float b,float c){float r;asm("v_max3_f32 %0, %1, %2, %3":"=v"(r):"v"(a),"v"(b),"v"(c));return r;}
__device__ __forceinline__ float max2f(float a,float b){float r;asm("v_max_f32_e32 %0, %1, %2":"=v"(r):"v"(a),"v"(b));return r;}
__device__ __forceinline__ float fadd_s(float a,float b){float r;asm("v_add_f32_e32 %0, %1, %2":"=v"(r):"v"(a),"v"(b));return r;}
__device__ __forceinline__ float fsub_s(float a,float b){float r;asm("v_sub_f32_e32 %0, %1, %2":"=v"(r):"v"(a),"v"(b));return r;}
typedef float f32x2_t __attribute__((ext_vector_type(2))); typedef __bf16 bf16x2_t __attribute__((ext_vector_type(2)));
__device__ __forceinline__ unsigned cvtpk_s(float lo,float hi){f32x2_t v={lo,hi};bf16x2_t b=__builtin_convertvector(v,bf16x2_t);return __builtin_bit_cast(unsigned,b);}
#define WAIT_BAR(N) asm volatile("s_waitcnt vmcnt(" #N ") lgkmcnt(0)\n\ts_barrier":::"memory")

__device__ __forceinline__ void qkt(f32x16&p0,f32x16&p1,const char*Kslot,const bf16x8*qr,int r32,int hi){
  const char*kb=Kslot+hi*1024+r32*16;
  #pragma unroll
  for(int d0=0;d0<4;++d0){
    const bf16x8 b0=*reinterpret_cast<const bf16x8*>(kb+d0*2048);
    const bf16x8 b1=*reinterpret_cast<const bf16x8*>(kb+d0*2048+512);
    {p0=__builtin_amdgcn_mfma_f32_32x32x16_bf16(b0,qr[d0],p0,0,0,0);p1=__builtin_amdgcn_mfma_f32_32x32x16_bf16(b1,qr[d0],p1,0,0,0);}}
}
typedef __attribute__((address_space(3))) const char* lds_cptr;
typedef short v4i16_t __attribute__((ext_vector_type(4)));
__device__ __forceinline__ void kload8(bf16x8*kf,lds_cptr kp){
  kf[0]=*(const __attribute__((address_space(3))) bf16x8*)(kp);      kf[1]=*(const __attribute__((address_space(3))) bf16x8*)(kp+512);
  kf[2]=*(const __attribute__((address_space(3))) bf16x8*)(kp+2048); kf[3]=*(const __attribute__((address_space(3))) bf16x8*)(kp+2560);
  kf[4]=*(const __attribute__((address_space(3))) bf16x8*)(kp+4096); kf[5]=*(const __attribute__((address_space(3))) bf16x8*)(kp+4608);
  kf[6]=*(const __attribute__((address_space(3))) bf16x8*)(kp+6144); kf[7]=*(const __attribute__((address_space(3))) bf16x8*)(kp+6656);
}
__device__ __forceinline__ void kload2(bf16x8*kf,lds_cptr kp,int j){ kf[2*j]=*(const __attribute__((address_space(3))) bf16x8*)(kp+j*2048); kf[2*j+1]=*(const __attribute__((address_space(3))) bf16x8*)(kp+j*2048+512); }
__device__ __forceinline__ s16x4 vtr(lds_cptr p){ return __builtin_bit_cast(s16x4,__builtin_amdgcn_ds_read_tr16_b64_v4i16((__attribute__((address_space(3))) v4i16_t*)p)); }
__device__ __forceinline__ float rowmax(const f32x16&p0,const f32x16&p1){
  float a=max3f(p0[0],p0[1],p1[0]),b=max3f(p0[2],p0[3],p1[1]);a=max3f(a,p1[2],p1[3]);
  #pragma unroll
  for(int r=4;r<16;r+=4){a=max3f(a,p0[r],p0[r+1]);b=max3f(b,p0[r+2],p0[r+3]);a=max3f(a,p1[r],p1[r+1]);b=max3f(b,p1[r+2],p1[r+3]);}
  const float m=max2f(a,b);
  auto rr=__builtin_amdgcn_permlane32_swap(__float_as_uint(m),__float_as_uint(m),false,false);
  return max2f(__uint_as_float(rr[0]),__uint_as_float(rr[1]));
}
__device__ __forceinline__ void pv(f32x16*o,int vb,bf16x8 pa0,bf16x8 pa1,bf16x8 pa2,bf16x8 pa3){
  #pragma unroll
  for(int d0=0;d0<2;++d0){s16x4 lo[4],hi[4];
    #pragma unroll
    for(int ks=0;ks<4;++ks){
      asm volatile("ds_read_b64_tr_b16 %0,%1 offset:%c2":"=&v"(lo[ks]):"v"(vb),"i"(d0*4096+ks*1024):"memory");
      asm volatile("ds_read_b64_tr_b16 %0,%1 offset:%c2":"=&v"(hi[ks]):"v"(vb),"i"(d0*4096+ks*1024+512):"memory");}
    asm volatile("s_waitcnt lgkmcnt(0)":::"memory");SBAR();
    #define PK(k) (bf16x8){lo[k][0],lo[k][1],lo[k][2],lo[k][3],hi[k][0],hi[k][1],hi[k][2],hi[k][3]}
    o[d0]=__builtin_amdgcn_mfma_f32_32x32x16_bf16(pa0,PK(0),o[d0],0,0,0);
    o[d0]=__builtin_amdgcn_mfma_f32_32x32x16_bf16(pa1,PK(1),o[d0],0,0,0);
    o[d0]=__builtin_amdgcn_mfma_f32_32x32x16_bf16(pa2,PK(2),o[d0],0,0,0);
    o[d0]=__builtin_amdgcn_mfma_f32_32x32x16_bf16(pa3,PK(3),o[d0],0,0,0);
    #undef PK
  }
}

#ifndef ATTN_STORE16
#define ATTN_STORE16(p,v) (*(u32x4*)(p)=(v))
#endif
template<int THRL> __device__ __forceinline__ void attn_unit(int b,int h,int qb,const bf16*Q,const bf16*__restrict__ K,const bf16*__restrict__ V,bf16*O,char*shm,const float*fxf,float bfh){
  int tid_o=threadIdx.x; asm volatile("":"+v"(tid_o)); const int tid=tid_o,lane=tid&63,r32=lane&31,hi=lane>>5; const int wid=__builtin_amdgcn_readfirstlane(tid>>6);
  const long rowbase=(long)b*SEQ; const int q0=qb*QB;
  const lds_cptr shm3b=(lds_cptr)shm;

  {
    float* bl=(float*)(shm+LDS_BIAS); float* sc=(float*)(shm+LDS_SCAN);
    const int nkeys=q0+QB; const int s0=4*tid; float c0=0.f,c1=0.f,c2=0.f,c3=0.f;
    if(s0<nkeys){ const float* fp=fxf+((long)(rowbase+s0))*8+h; float z0=fp[0]+bfh,z1=fp[8]+bfh,z2=fp[16]+bfh,z3=fp[24]+bfh;
      c0=fminf(z0,0.f)-log1pf(expf(-fabsf(z0))); c1=c0+(fminf(z1,0.f)-log1pf(expf(-fabsf(z1)))); c2=c1+(fminf(z2,0.f)-log1pf(expf(-fabsf(z2)))); c3=c2+(fminf(z3,0.f)-log1pf(expf(-fabsf(z3)))); }
    float incl=c3;
    #pragma unroll
    for(int o=1;o<64;o<<=1){ const float t_=__shfl_up(incl,o); if(lane>=o)incl+=t_; }
    if(lane==63)sc[wid]=incl;
    __syncthreads();
    float woff=0.f;
    #pragma unroll
    for(int w_=0;w_<NW;++w_){ const float t_=sc[w_]; if(w_<wid)woff+=t_; }
    const float excl=woff+incl-c3; c0+=excl;c1+=excl;c2+=excl;c3+=excl;
    if(s0<nkeys){ bl[s0]=c0; bl[s0+1]=c1; bl[s0+2]=c2; bl[s0+3]=c3; }
    __syncthreads();
    const float cref=bl[q0];
    __syncthreads();
    const float L2E=1.4426950408889634f;
    if(s0<nkeys){ bl[s0]=(cref-c0)*L2E; bl[s0+1]=(cref-c1)*L2E; bl[s0+2]=(cref-c2)*L2E; bl[s0+3]=(cref-c3)*L2E; }
    __syncthreads();
  }
  const __attribute__((address_space(3))) float* bias3=(const __attribute__((address_space(3))) float*)(shm3b+LDS_BIAS)+4*hi;
  #define CINIT(P0,P1,t) do{ const __attribute__((address_space(3))) float* bp_=bias3+64*(t); \
    _Pragma("unroll") for(int g_=0;g_<4;++g_){ const f32x4b b0_=*(const __attribute__((address_space(3))) f32x4b*)(bp_+8*g_); const f32x4b b1_=*(const __attribute__((address_space(3))) f32x4b*)(bp_+32+8*g_); \
      P0[4*g_]=b0_[0]-mhat;P0[4*g_+1]=b0_[1]-mhat;P0[4*g_+2]=b0_[2]-mhat;P0[4*g_+3]=b0_[3]-mhat; P1[4*g_]=b1_[0]-mhat;P1[4*g_+1]=b1_[1]-mhat;P1[4*g_+2]=b1_[2]-mhat;P1[4*g_+3]=b1_[3]-mhat; } }while(0)
  const bf16*Qw=Q+(rowbase+q0+wid*QBLK)*DM+h*D;
  const bf16*Kh=K+rowbase*DM+h*D,*Vh=V+rowbase*DM+h*D;
  const unsigned lds0=(unsigned)(uintptr_t)shm;
  float*wsf=(float*)(shm+LDS_WS)+wid*64;
  const bf16*ksrc=Kh+(long)lane*DM+wid*8;
  const bf16*vsrc=Vh+(long)(16*(wid&3)+(lane>>2))*DM+(wid>>2)*32+(lane&3)*8;
  const unsigned kdst=lds0+LDS_K+wid*1024, vdst=lds0+LDS_V+wid*1024;
  #define DMA_K(t,slot) glds16(ksrc+(long)(t)*KVBLK*DM,(unsigned)__builtin_amdgcn_readfirstlane(kdst+(slot)))
  #define DMA_V(t,slot) glds16(vsrc+(long)(t)*KVBLK*DM,(unsigned)__builtin_amdgcn_readfirstlane(vdst+(slot)))
  const int vb0=(int)(lds0+LDS_V)+((lane>>4)&1)*32+(lane&3)*8+(4*hi+((lane&15)>>2))*64;
  const char*Kbase=shm+LDS_K; bf16x8 kf[8];
  const lds_cptr shm3=(lds_cptr)shm; const lds_cptr kp0=shm3+LDS_K+hi*1024+r32*16; const lds_cptr vp0=shm3+LDS_V+((lane>>4)&1)*32+(lane&3)*8+(4*hi+((lane&15)>>2))*64;
  const int NT=(q0+QB)/KVBLK;
  DMA_K(0,0);DMA_V(0,0);DMA_K(1,SLOTB);
  bf16x8 qr[4];
  #pragma unroll
  for(int d0=0;d0<4;++d0)qr[d0]=*reinterpret_cast<const bf16x8*>(&Qw[(long)r32*DM+d0*16+hi*8]);
  float mhat=0.f,l_reg=0.f;f32x16 o[2];o[0]=f32x16{};o[1]=f32x16{};
  const int qrel=wid*QBLK+r32;
  #define CMASK(P0,P1,t) do{int jb_=(t)-(NT-4); if(jb_>=0)cmask(P0,P1,jb_,qrel,hi);}while(0)
  bool resc=false;
  #define START(P0,P1) do{ const float rm=rowmax(P0,P1); resc=false; \
    { const float dl=rm; mhat=fadd_s(mhat,dl); \
      _Pragma("unroll") for(int r=0;r<16;++r){P0[r]=fsub_s(P0[r],dl);P1[r]=fsub_s(P1[r],dl);} \
      } \
    _Pragma("unroll") for(int r=0;r<16;++r)P0[r]=__builtin_amdgcn_exp2f(P0[r]); }while(0)
  #define RESC() do{ if(resc){ asm volatile("s_waitcnt lgkmcnt(0)":::"memory"); \
      _Pragma("unroll") for(int d_=0;d_<2;++d_) _Pragma("unroll") for(int r=0;r<16;++r)o[d_][r]*=wsf[crow(r,hi)]; } }while(0)
  f32x16 pA0,pA1,pB0,pB1;
  int sl_prev=0,sl_cur=0,sl_next=SLOTB;
  #define ROT() do{sl_prev=sl_cur;sl_cur=sl_next;sl_next=(sl_next==(NSLOT-1)*SLOTB)?0:sl_next+SLOTB;}while(0)
  DMA_K(2,2*SLOTB);
  WAIT_BAR(3);
  CINIT(pA0,pA1,0); qkt(pA0,pA1,Kbase,qr,r32,hi);asm volatile("s_nop 15\n\ts_nop 7":"+v"(pA0),"+v"(pA1));CMASK(pA0,pA1,0);
  START(pA0,pA1);
  _Pragma("unroll") for(int r=0;r<16;++r)pA1[r]=__builtin_amdgcn_exp2f(pA1[r]);
  WAIT_BAR(0);
  DMA_K(3,0);DMA_V(1,SLOTB);
  ROT();
  kload8(kf,kp0+sl_cur);
  WAIT_BAR(2);
  s16x4 vlo[8],vhi[8]; u32x4 pw0,pw1,pw2,pw3;
  #define PKW(P,B) cvtpk_s(P[B],P[B+1])
  #define PAF(k) __builtin_bit_cast(bf16x8,pw##k)
  #define VFR(i) (bf16x8){vlo[i][0],vlo[i][1],vlo[i][2],vlo[i][3],vhi[i][0],vhi[i][1],vhi[i][2],vhi[i][3]}
  #define PIN(x) asm volatile("":"+v"(x))
  #define MX3(a,b,c) __builtin_fmaxf(__builtin_fmaxf((a),(b)),(c))
  #define GAPA(MF,A0,A1,A2,A3,W0,W1,PW) do{ MF; sacc+=A0; sacc+=A1; sacc+=A2; sacc+=A3; PIN(sacc); W0; W1; PIN(PW); SBAR(); }while(0)
  #define EX(v) __builtin_amdgcn_exp2f(v)
  #define GAPB(MF,X,B) do{ MF; X[B]=EX(X[B]); X[B+1]=EX(X[B+1]); X[B+2]=EX(X[B+2]); X[B+3]=EX(X[B+3]); PIN(X); SBAR(); }while(0)
  #define VRD(i) do{ vlo[i]=vtr(vp_+(((i)>>2)*4096+((i)&3)*1024)); vhi[i]=vtr(vp_+(((i)>>2)*4096+((i)&3)*1024+512)); }while(0)
  #define KRD(G,j) do{ if(G){ kload2(kf,kp0+sl_next,j); SBAR(); } }while(0)
  #define STEP(C0,C1,P0,P1,t,GK,GV,GL) do{ SBAR(); CINIT(C0,C1,t); SBAR(); \
    const lds_cptr vp_=vp0+sl_prev; \
    VRD(0); SBAR(); float sacc=(P0[0]+P0[1]); \
    GAPA(C0=__builtin_amdgcn_mfma_f32_32x32x16_bf16(kf[0],qr[0],C0,0,0,0), P0[2],P0[3],P0[4],P0[5],     pw0[0]=PKW(P0,0), pw0[1]=PKW(P0,2), pw0); \
    VRD(4); SBAR(); GAPA(C1=__builtin_amdgcn_mfma_f32_32x32x16_bf16(kf[1],qr[0],C1,0,0,0), P0[6],P0[7],P0[8],P0[9],     pw0[2]=PKW(P0,4), pw0[3]=PKW(P0,6), pw0); \
    VRD(1); SBAR(); GAPA(C0=__builtin_amdgcn_mfma_f32_32x32x16_bf16(kf[2],qr[1],C0,0,0,0),   P0[10],P0[11],P0[12],P0[13], pw1[0]=PKW(P0,8), pw1[1]=PKW(P0,10), pw1); \
    VRD(5); SBAR(); GAPA(C1=__builtin_amdgcn_mfma_f32_32x32x16_bf16(kf[3],qr[1],C1,0,0,0),   P0[14],P0[15],P1[0],P1[1],   pw1[2]=PKW(P0,12),pw1[3]=PKW(P0,14), pw1); \
    VRD(2); SBAR(); GAPA(C0=__builtin_amdgcn_mfma_f32_32x32x16_bf16(kf[4],qr[2],C0,0,0,0),   P1[2],P1[3],P1[4],P1[5],     pw2[0]=PKW(P1,0), pw2[1]=PKW(P1,2), pw2); \
    VRD(6); SBAR(); GAPA(C1=__builtin_amdgcn_mfma_f32_32x32x16_bf16(kf[5],qr[2],C1,0,0,0),   P1[6],P1[7],P1[8],P1[9],     pw2[2]=PKW(P1,4), pw2[3]=PKW(P1,6), pw2); \
    VRD(3); SBAR(); GAPA(C0=__builtin_amdgcn_mfma_f32_32x32x16_bf16(kf[6],qr[3],C0,0,0,0),   P1[10],P1[11],P1[12],P1[13], pw3[0]=PKW(P1,8), pw3[1]=PKW(P1,10), pw3); \
    VRD(7); SBAR(); GAPA(C1=__builtin_amdgcn_mfma_f32_32x32x16_bf16(kf[7],qr[3],C1,0,0,0),   P1[14],P1[15],0.f,0.f,       pw3[2]=PKW(P1,12),pw3[3]=PKW(P1,14), pw3); \
    l_reg+=sacc; \
    if(GK){DMA_K((t)+3,sl_cur);} if(GV){DMA_V((t)+1,sl_next);} \
    CMASK(C0,C1,t); \
    { float a=MX3(C0[0],C0[1],C1[0]),b=MX3(C0[2],C0[3],C1[1]); a=MX3(a,C1[2],C1[3]); \
      _Pragma("unroll") for(int r=4;r<16;r+=4){a=MX3(a,C0[r],C0[r+1]);b=MX3(b,C0[r+2],C0[r+3]);a=MX3(a,C1[r],C1[r+1]);b=MX3(b,C1[r+2],C1[r+3]);} \
      float rm=__builtin_fmaxf(a,b); { auto rr=__builtin_amdgcn_permlane32_swap(__float_as_uint(rm),__float_as_uint(rm),false,false); rm=__builtin_fmaxf(__uint_as_float(rr[0]),__uint_as_float(rr[1])); } \
      resc=false; \
      if(__builtin_expect(__any(rm>(float)THRL),0)){ const float dl=__builtin_fmaxf(rm,0.f); mhat+=dl; \
        _Pragma("unroll") for(int r=0;r<16;++r){C0[r]-=dl;C1[r]-=dl;} \
        const float f=__builtin_amdgcn_exp2f(-dl); l_reg*=f; if(hi==0)wsf[r32]=f; resc=true; } } \
    SBAR(); \
    GAPB(o[0]=__builtin_amdgcn_mfma_f32_32x32x16_bf16(PAF(0),VFR(0),o[0],0,0,0), C0,0); \
    GAPB(o[1]=__builtin_amdgcn_mfma_f32_32x32x16_bf16(PAF(0),VFR(4),o[1],0,0,0), C0,4); \
    KRD(GL,0); GAPB(o[0]=__builtin_amdgcn_mfma_f32_32x32x16_bf16(PAF(1),VFR(1),o[0],0,0,0), C0,8); \
    KRD(GL,1); GAPB(o[1]=__builtin_amdgcn_mfma_f32_32x32x16_bf16(PAF(1),VFR(5),o[1],0,0,0), C0,12); \
    KRD(GL,2); GAPB(o[0]=__builtin_amdgcn_mfma_f32_32x32x16_bf16(PAF(2),VFR(2),o[0],0,0,0), C1,0); \
    KRD(GL,3); GAPB(o[1]=__builtin_amdgcn_mfma_f32_32x32x16_bf16(PAF(2),VFR(6),o[1],0,0,0), C1,4); \
    GAPB(o[0]=__builtin_amdgcn_mfma_f32_32x32x16_bf16(PAF(3),VFR(3),o[0],0,0,0), C1,8); \
    GAPB(o[1]=__builtin_amdgcn_mfma_f32_32x32x16_bf16(PAF(3),VFR(7),o[1],0,0,0), C1,12); \
    }while(0)
  int t=1;
  #undef CMASK
  #define CMASK(P0,P1,t) do{}while(0)
  for(;t+5<NT;t+=2){
    STEP(pB0,pB1,pA0,pA1,t,true,true,true);     WAIT_BAR(2); RESC(); ROT();
    STEP(pA0,pA1,pB0,pB1,t+1,true,true,true);   WAIT_BAR(2); RESC(); ROT();
  }
  #undef CMASK
  #define CMASK(P0,P1,t) do{int jb_=(t)-(NT-4); if(jb_>=0)cmask(P0,P1,jb_,qrel,hi);}while(0)
  #define ENDW(tt) do{ if((tt)+3<NT){WAIT_BAR(2);} else if((tt)+2<NT){WAIT_BAR(1);} else {WAIT_BAR(0);} }while(0)
  for(;t+1<NT;t+=2){
    STEP(pB0,pB1,pA0,pA1,t,(t+3<NT),(t+1<NT),(t+1<NT));       ENDW(t);   RESC(); ROT();
    STEP(pA0,pA1,pB0,pB1,t+1,(t+4<NT),(t+2<NT),(t+2<NT));     ENDW(t+1); RESC(); ROT();
  }
  STEP(pB0,pB1,pA0,pA1,NT-1,false,false,false); RESC();
  { float sacc=pB0[0]+pB0[1]; _Pragma("unroll") for(int r=2;r<16;++r)sacc+=pB0[r]; _Pragma("unroll") for(int r=0;r<16;++r)sacc+=pB1[r]; l_reg+=sacc;
    pw0=(u32x4){PKW(pB0,0),PKW(pB0,2),PKW(pB0,4),PKW(pB0,6)};pw1=(u32x4){PKW(pB0,8),PKW(pB0,10),PKW(pB0,12),PKW(pB0,14)};pw2=(u32x4){PKW(pB1,0),PKW(pB1,2),PKW(pB1,4),PKW(pB1,6)};pw3=(u32x4){PKW(pB1,8),PKW(pB1,10),PKW(pB1,12),PKW(pB1,14)};
    SBAR(); pv(o,vb0+sl_cur,PAF(0),PAF(1),PAF(2),PAF(3)); }
  #undef PKW
  #undef PAF
  #undef VFR
  #undef PIN
  #undef MX3
  #undef GAPA
  #undef GAPB
  #undef EX
  #undef VRD
  #undef KRD
  #undef STEP
  #undef ENDW
  {auto rr=__builtin_amdgcn_permlane32_swap(__float_as_uint(l_reg),__float_as_uint(l_reg),false,false);l_reg=__uint_as_float(rr[0])+__uint_as_float(rr[1]);}
  if(hi==0)wsf[32+r32]=l_reg;asm volatile("s_waitcnt lgkmcnt(0)":::"memory");
  float rli[16];
  #pragma unroll
  for(int r=0;r<16;++r)rli[r]=__builtin_amdgcn_rcpf(wsf[32+crow(r,hi)]);
  bf16*Ow=O+(rowbase+q0+wid*QBLK)*DM+h*D;
  { bf16*stg=(bf16*)(shm+LDS_OST)+wid*2048;
    #pragma unroll
    for(int r=0;r<16;++r){const int orow=crow(r,hi);
      #pragma unroll
      for(int d0=0;d0<2;++d0)stg[orow*64+d0*32+r32]=__float2bfloat16(o[d0][r]*rli[r]);}
    asm volatile("s_waitcnt lgkmcnt(0)":::"memory");
    #pragma unroll
    for(int i=0;i<4;++i){const int row=i*8+(lane>>3),ch=lane&7; const u32x4 v=*(const u32x4*)(stg+row*64+ch*8); ATTN_STORE16(Ow+(long)row*DM+ch*8,v);} }
  asm volatile("s_waitcnt lgkmcnt(0)\n\ts_barrier":::"memory");
  #undef CINIT
  #undef DMA_K
  #undef DMA_V
  #undef CMASK
  #undef START
  #undef RESC
  #undef ROT
}
constexpr int ATTN_LDS_BYTES=LDS_BYTES;
struct AttnTensors { const bf16* Q; const bf16* K; const bf16* V; bf16* O; const float* fxf; const float* bf; };
struct AttnUnit { int bh; int qb; };
struct StaticOrder {
  int vcu;
  __device__ __forceinline__ explicit StaticOrder(int grid,int block):vcu((grid%8==0)?((block%8)*(grid/8)+block/8):block){}
  __device__ __forceinline__ bool next(int i,AttnUnit&u)const{ const int idx=vcu+ (i>>1)*0; if(i>=2||idx>=256)return false; const int s=idx&3; u.bh=idx>>2; u.qb=(i==0)?s:7-s; return true; }
  __device__ __forceinline__ void a_ready(const AttnUnit&)const{}
  __device__ __forceinline__ void done(const AttnUnit&)const{}
};
template<class Sched,int THRL=8> __device__ __forceinline__ void attn_phase(char*lds,const AttnTensors&T,const Sched&S){
  AttnUnit u;
  for(int i=0;S.next(i,u);++i){ S.a_ready(u); attn_unit<THRL>(u.bh/NHEAD,u.bh%NHEAD,u.qb,T.Q,T.K,T.V,T.O,lds,T.fxf,T.bf[u.bh%NHEAD]); S.done(u); }
}
#undef SBAR
#undef WAIT_BAR
}

constexpr int M = 16384, DMOD = 1024, SEQL = 2048, FFN_H = 2816, INTOT = 7176;
constexpr size_t MiB = 1u << 20;
constexpr size_t WS_HB = 0, WS_HBL = 32 * MiB, WS_YA = 64 * MiB, WS_YB = 80 * MiB, WS_YC = 96 * MiB;
constexpr size_t WS_FK = WS_YA, WS_FQ = WS_YB, WS_FV = WS_YC;
constexpr size_t WS_ZQ = 112 * MiB, WS_ZF = 128 * MiB, WS_ZI = 160 * MiB, WS_ZG = 176 * MiB, WS_SU = 192 * MiB, WS_KV = 208 * MiB, WS_SE = 240 * MiB, WS_MISC = 248 * MiB;
constexpr size_t WS_GATES = 112 * MiB, WS_MERGED = 208 * MiB, WS_PRE = 112 * MiB, WS_H1B = 176 * MiB, WS_FFH = 0;
constexpr size_t MISC_FXF = 0, MISC_DEC = 1 * MiB, MISC_LB = 2 * MiB;
constexpr size_t DO_WIN = 0, DO_WGLU = 14 * MiB, DO_WBR = 14 * MiB + MiB / 2, DO_WOUT = 17 * MiB + MiB / 2, DO_WGU = 19 * MiB + MiB / 2, DO_WDN = 30 * MiB + MiB / 2,
                 DO_TM = 36 * MiB, DO_EM = 42 * MiB, DO_LAM = 44 * MiB, DO_YG = 48 * MiB;
constexpr int LDS_BYTES = 147456;
constexpr float DN_ALPHA = 1.4142135623730951f, LN_EPS = 1e-5f, RMS_EPS = 1e-6f;

typedef unsigned short u16;
typedef unsigned v4u __attribute__((ext_vector_type(4)));
typedef unsigned v2u __attribute__((ext_vector_type(2)));
typedef float f32x4 __attribute__((ext_vector_type(4)));
typedef short bf16x8 __attribute__((ext_vector_type(8)));
__device__ __forceinline__ unsigned f2bf(float f) { unsigned u = __builtin_bit_cast(unsigned, f); return (u + 0x7fffu + ((u >> 16) & 1u)) >> 16; }
__device__ __forceinline__ unsigned pk2(float lo, float hi) { return f2bf(lo) | (f2bf(hi) << 16); }
__device__ __forceinline__ float bf2f(unsigned h) { return __builtin_bit_cast(float, h << 16); }
__device__ __forceinline__ float bflo(unsigned w) { return __builtin_bit_cast(float, w << 16); }
__device__ __forceinline__ float bfhi(unsigned w) { return __builtin_bit_cast(float, w & 0xffff0000u); }
__device__ __forceinline__ float sigm(float x) { return 1.f / (1.f + __expf(-x)); }
__device__ __forceinline__ float wave_sum(float v) {
#pragma unroll
    for (int o = 1; o < 64; o <<= 1) v += __shfl_xor(v, o);
    return v;
}

struct Args { const float* in[25]; float* out; unsigned char* ws; };

namespace pg8 {
struct EpiIn {
    static constexpr bool PERM = true, AFTER_DRAIN = false, KEEP_ACC = false;
    unsigned char* ws; const float* lb; float c2;
    __device__ __forceinline__ void operator()(f32x4 (&acc)[2][2][4][2], const Unit& u, int wr, int wc, int fr, int fq) const {
        const int seg = u.pn >> 1;
        const int cbase = (u.pn & 1) * 256 + wc * 32 + 8 * fq;
        const int row0 = (u.pm * BM) + wr * 64 + fr;
#pragma unroll
        for (int ai = 0; ai < 2; ++ai)
#pragma unroll
            for (int m = 0; m < 4; ++m) {
                const int row = row0 + ai * HALF + m * 16;
#pragma unroll
                for (int bj = 0; bj < 2; ++bj) {
                    const int c = cbase + bj * HALF;
                    f32x4 v0 = acc[ai][bj][m][0], v1 = acc[ai][bj][m][1];
                    if (seg == 1) {
                        const f32x4 l0 = *(const f32x4*)(lb + c), l1 = *(const f32x4*)(lb + c + 4);
#pragma unroll
                        for (int e = 0; e < 4; ++e) { v0[e] = __logf(l0[e] + (1.f - l0[e]) * sigm(v0[e])); v1[e] = __logf(l1[e] + (1.f - l1[e]) * sigm(v1[e])); }
                        float* p = (float*)(ws + WS_ZF) + (size_t)row * 512 + c;
                        *(f32x4*)p = v0; *(f32x4*)(p + 4) = v1;
                    } else {
                        if (seg == 4) { v0 = v0 * c2; v1 = v1 * c2; }
                        u32x4 w; w.x = cvt_pk_bf16(v0[0], v0[1]); w.y = cvt_pk_bf16(v0[2], v0[3]); w.z = cvt_pk_bf16(v1[0], v1[1]); w.w = cvt_pk_bf16(v1[2], v1[3]);
                        size_t off;
                        if (seg == 7) off = WS_SU + 2 * (((size_t)((c >> 4) * 1024 + (row >> 4))) * 256 + (size_t)((row & 15) * 16 + (c & 15)));
                        else {
                            const size_t base = seg == 0 ? WS_ZQ : seg == 2 ? WS_ZI : seg == 3 ? WS_ZG : seg == 4 ? WS_FQ : seg == 5 ? WS_FK : WS_FV;
                            off = base + 2 * ((size_t)row * 512 + c);
                        }
                        *(u32x4*)(ws + off) = w;
                    }
                }
            }
    }
};
struct EpiGate {
    static constexpr bool PERM = true, AFTER_DRAIN = false, KEEP_ACC = false;
    bf16_t* G;
    __device__ __forceinline__ void operator()(f32x4 (&acc)[2][2][4][2], const Unit& u, int wr, int wc, int fr, int fq) const {
        const int col0 = u.pn * BM + wc * 32 + 8 * fq, row0 = u.pm * BM + wr * 64 + fr;
#pragma unroll
        for (int ai = 0; ai < 2; ++ai)
#pragma unroll
            for (int m = 0; m < 4; ++m) { bf16_t* rowp = G + (size_t)(row0 + ai * HALF + m * 16) * 3072 + col0;
#pragma unroll
                for (int bj = 0; bj < 2; ++bj) { const f32x4 v0 = acc[ai][bj][m][0], v1 = acc[ai][bj][m][1];
                    u32x4 w; w.x = cvt_pk_bf16(sigm(v0[0]), sigm(v0[1])); w.y = cvt_pk_bf16(sigm(v0[2]), sigm(v0[3])); w.z = cvt_pk_bf16(sigm(v1[0]), sigm(v1[1])); w.w = cvt_pk_bf16(sigm(v1[2]), sigm(v1[3]));
                    *(u32x4*)(rowp + bj * HALF) = w; } }
    }
};
struct EpiGlu {
    static constexpr bool PERM = true, AFTER_DRAIN = false, KEEP_ACC = false;
    const bf16_t* Y; bf16_t* O;
    __device__ __forceinline__ void operator()(f32x4 (&acc)[2][2][4][2], const Unit& u, int wr, int wc, int fr, int fq) const {
        const int col0 = u.pn * BM + wc * 32 + 8 * fq, row0 = u.pm * BM + wr * 64 + fr;
#pragma unroll
        for (int ai = 0; ai < 2; ++ai)
#pragma unroll
            for (int m = 0; m < 4; ++m) { const size_t ro = (size_t)(row0 + ai * HALF + m * 16) * 512 + col0;
#pragma unroll
                for (int bj = 0; bj < 2; ++bj) { const f32x4 v0 = acc[ai][bj][m][0], v1 = acc[ai][bj][m][1];
                    const u32x4 y = *(const u32x4*)(Y + ro + bj * HALF);
                    u32x4 w; w.x = cvt_pk_bf16(bflo(y.x) * sigm(v0[0]), bfhi(y.x) * sigm(v0[1])); w.y = cvt_pk_bf16(bflo(y.y) * sigm(v0[2]), bfhi(y.y) * sigm(v0[3]));
                    w.z = cvt_pk_bf16(bflo(y.z) * sigm(v1[0]), bfhi(y.z) * sigm(v1[1])); w.w = cvt_pk_bf16(bflo(y.w) * sigm(v1[2]), bfhi(y.w) * sigm(v1[3]));
                    *(u32x4*)(O + ro + bj * HALF) = w; } }
    }
};
struct EpiBranch {
    static constexpr bool PERM = true, AFTER_DRAIN = false, KEEP_ACC = true;
    const bf16_t* G; bf16_t* O;
    __device__ __forceinline__ void operator()(f32x4 (&acc)[2][2][4][2], const Unit& u, int wr, int wc, int fr, int fq) const {
        const int br = u.pm >> 6, tm = u.pm & 63, tn = u.pn & 3;
        const int col0 = tn * BM + wc * 32 + 8 * fq, row0 = tm * BM + wr * 64 + fr;
#pragma unroll
        for (int ai = 0; ai < 2; ++ai)
#pragma unroll
            for (int m = 0; m < 4; ++m) { const size_t row = (size_t)(row0 + ai * HALF + m * 16);
#pragma unroll
                for (int bj = 0; bj < 2; ++bj) { f32x4 v0 = acc[ai][bj][m][0], v1 = acc[ai][bj][m][1];
                    const bf16_t* gp = G + row * 3072 + col0 + bj * HALF;
                    if (br < 2) {
                        const u32x4 ga = *(const u32x4*)(gp + br * 1024), gb = *(const u32x4*)(gp + (br + 1) * 1024);
                        v0[0] *= bflo(ga.x) * __builtin_amdgcn_rcpf(bflo(gb.x)); v0[1] *= bfhi(ga.x) * __builtin_amdgcn_rcpf(bfhi(gb.x));
                        v0[2] *= bflo(ga.y) * __builtin_amdgcn_rcpf(bflo(gb.y)); v0[3] *= bfhi(ga.y) * __builtin_amdgcn_rcpf(bfhi(gb.y));
                        v1[0] *= bflo(ga.z) * __builtin_amdgcn_rcpf(bflo(gb.z)); v1[1] *= bfhi(ga.z) * __builtin_amdgcn_rcpf(bfhi(gb.z));
                        v1[2] *= bflo(ga.w) * __builtin_amdgcn_rcpf(bflo(gb.w)); v1[3] *= bfhi(ga.w) * __builtin_amdgcn_rcpf(bfhi(gb.w));
                        acc[ai][bj][m][0] = v0; acc[ai][bj][m][1] = v1;
                    } else {
                        const u32x4 ga = *(const u32x4*)(gp + 2048);
                        u32x4 w; w.x = cvt_pk_bf16(v0[0] * bflo(ga.x), v0[1] * bfhi(ga.x)); w.y = cvt_pk_bf16(v0[2] * bflo(ga.y), v0[3] * bfhi(ga.y));
                        w.z = cvt_pk_bf16(v1[0] * bflo(ga.z), v1[1] * bfhi(ga.z)); w.w = cvt_pk_bf16(v1[2] * bflo(ga.w), v1[3] * bfhi(ga.w));
                        *(u32x4*)(O + row * 1024 + col0 + bj * HALF) = w;
                        acc[ai][bj][m][0] = (f32x4){0.f, 0.f, 0.f, 0.f}; acc[ai][bj][m][1] = (f32x4){0.f, 0.f, 0.f, 0.f};
                    } } }
    }
};
struct BranchOrder {
    StaticOrder so;
    __host__ __device__ void init(int G_, int c_) { so.init(16384, 1024, G_, c_); }
    __host__ __device__ bool next(int i, Unit& u) const { const int r = i / 3, br = i - 3 * r; Unit t; if (!so.next(r, t)) return false; u.pm = t.pm + 64 * br; u.pn = t.pn + 4 * br; return true; }
    __device__ __forceinline__ void a_ready(const Unit&) const {}
    __device__ __forceinline__ void done(const Unit&) const {}
};
struct EpiRes {
    static constexpr bool PERM = false, AFTER_DRAIN = false, KEEP_ACC = false;
    const float* resf; const bf16_t* rhi; const bf16_t* rlo; float* out;
    __device__ __forceinline__ void operator()(f32x4 (&acc)[2][2][4][2], const Unit& u, int wr, int wc, int fr, int fq) const {
        const int col0 = u.pn * BM + wc * 32 + 4 * fq, row0 = u.pm * BM + wr * 64 + fr;
#pragma unroll
        for (int ai = 0; ai < 2; ++ai)
#pragma unroll
            for (int m = 0; m < 4; ++m) { const size_t ro = (size_t)(row0 + ai * HALF + m * 16) * 1024 + col0;
#pragma unroll
                for (int bj = 0; bj < 2; ++bj)
#pragma unroll
                    for (int n = 0; n < 2; ++n) { const size_t o = ro + bj * HALF + n * 16; f32x4 r;
                        if (resf) r = *(const f32x4*)(resf + o);
                        else { const v2u h = *(const v2u*)(rhi + o), l = *(const v2u*)(rlo + o); r[0] = bflo(h.x) + bflo(l.x); r[1] = bfhi(h.x) + bfhi(l.x); r[2] = bflo(h.y) + bflo(l.y); r[3] = bfhi(h.y) + bfhi(l.y); }
                        *(f32x4*)(out + o) = r * 1.4142135623730951f + acc[ai][bj][m][n]; } }
    }
};
struct EpiSwiglu {
    static constexpr bool PERM = true, AFTER_DRAIN = false, KEEP_ACC = false;
    bf16_t* O;
    __device__ __forceinline__ void operator()(f32x4 (&acc)[2][2][4][2], const Unit& u, int wr, int wc, int fr, int fq) const {
        const int col0 = u.pn * 128 + wc * 32 + 8 * fq, row0 = u.pm * BM + wr * 64 + fr;
#pragma unroll
        for (int ai = 0; ai < 2; ++ai)
#pragma unroll
            for (int m = 0; m < 4; ++m) { const f32x4 g0 = acc[ai][0][m][0], g1 = acc[ai][0][m][1], u0 = acc[ai][1][m][0], u1 = acc[ai][1][m][1];
                u32x4 w; w.x = cvt_pk_bf16(g0[0] * sigm(g0[0]) * u0[0], g0[1] * sigm(g0[1]) * u0[1]); w.y = cvt_pk_bf16(g0[2] * sigm(g0[2]) * u0[2], g0[3] * sigm(g0[3]) * u0[3]);
                w.z = cvt_pk_bf16(g1[0] * sigm(g1[0]) * u1[0], g1[1] * sigm(g1[1]) * u1[1]); w.w = cvt_pk_bf16(g1[2] * sigm(g1[2]) * u1[2], g1[3] * sigm(g1[3]) * u1[3]);
                *(u32x4*)(O + (size_t)(row0 + ai * HALF + m * 16) * 2816 + col0) = w; }
    }
};
}

struct Frame { unsigned char* lds; unsigned char* ws; unsigned char* dout; int G, vcu; };
__device__ __forceinline__ int opq_tid() { int t = threadIdx.x; asm volatile("" : "+v"(t)); return t; }
#define F_TID (opq_tid())
#define F_LANE (opq_tid() & 63)
#define F_WAVE (__builtin_amdgcn_readfirstlane(opq_tid() >> 6))

__device__ __forceinline__ void cvt_item(const float* src, int ld, int K, int ncb, u16* dst, int grp, int stride, int base, int item, float* scr, int lane) {
    const int kb = item / ncb, nb = item - kb * ncb, k0 = 64 * kb, n0 = 32 * nb;
#pragma unroll 8
    for (int i = 0; i < 32; ++i) { const int kk = 2 * i + (lane >> 5); scr[kk * 33 + (lane & 31)] = src[(size_t)(k0 + kk) * ld + n0 + (lane & 31)]; }
    asm volatile("s_waitcnt lgkmcnt(0)" ::: "memory");
    const int c = lane & 7;
    const int drow0 = base + (n0 / grp) * stride + (n0 % grp);
#pragma unroll
    for (int j = 0; j < 4; ++j) { const int n = (lane >> 3) + 8 * j; const float* s = scr + (8 * c) * 33 + n;
        v4u o; o.x = pk2(s[0 * 33], s[1 * 33]); o.y = pk2(s[2 * 33], s[3 * 33]); o.z = pk2(s[4 * 33], s[5 * 33]); o.w = pk2(s[6 * 33], s[7 * 33]);
        *(v4u*)(dst + (size_t)(drow0 + n) * K + k0 + 8 * c) = o; }
    asm volatile("s_waitcnt lgkmcnt(0)" ::: "memory");
}
__device__ __forceinline__ void convert_weights(const Frame& F, const Args& a, int l) {
    float* scr = (float*)(F.lds + F_WAVE * 16384);
    const int gw = F.vcu * 8 + F_WAVE, NGW = F.G * 8;
    const float* win = a.in[1] + (size_t)l * DMOD * INTOT;
    unsigned char* d = F.dout;
    constexpr int BIG = 1 << 30;
    constexpr int I0 = 16 * 112, I1 = 16 * 16, I2 = 16 * 96, I3 = 8 * 16, I4 = 8 * 32, I7 = 16 * 32, I8 = 16 * 88, I10 = 44 * 32;
    constexpr int NIT = I0 + I1 + I2 + I3 + 3 * I4 + I7 + 2 * I8 + I10;
    for (int it = gw; it < NIT; it += NGW) {
        int r = it;
        if (r < I0) { cvt_item(win, INTOT, 1024, 112, (u16*)(d + DO_WIN), BIG, 0, 0, r, scr, F_LANE); continue; } r -= I0;
        if (r < I1) { cvt_item(win + 3592, INTOT, 1024, 16, (u16*)(d + DO_WIN), BIG, 0, 3584, r, scr, F_LANE); continue; } r -= I1;
        if (r < I2) { cvt_item(win + 4104, INTOT, 1024, 96, (u16*)(d + DO_WIN), BIG, 0, 4096, r, scr, F_LANE); continue; } r -= I2;
        if (r < I3) { cvt_item(a.in[13] + (size_t)l * 512 * 512, 512, 512, 16, (u16*)(d + DO_WGLU), BIG, 0, 0, r, scr, F_LANE); continue; } r -= I3;
        if (r < I4) { cvt_item(a.in[14] + (size_t)l * 512 * 1024, 1024, 512, 32, (u16*)(d + DO_WBR), BIG, 0, 0, r, scr, F_LANE); continue; } r -= I4;
        if (r < I4) { cvt_item(a.in[15] + (size_t)l * 512 * 1024, 1024, 512, 32, (u16*)(d + DO_WBR), BIG, 0, 1024, r, scr, F_LANE); continue; } r -= I4;
        if (r < I4) { cvt_item(a.in[16] + (size_t)l * 512 * 1024, 1024, 512, 32, (u16*)(d + DO_WBR), BIG, 0, 2048, r, scr, F_LANE); continue; } r -= I4;
        if (r < I7) { cvt_item(a.in[17] + (size_t)l * 1024 * 1024, 1024, 1024, 32, (u16*)(d + DO_WOUT), BIG, 0, 0, r, scr, F_LANE); continue; } r -= I7;
        if (r < I8) { cvt_item(a.in[20] + (size_t)l * 1024 * FFN_H, FFN_H, 1024, 88, (u16*)(d + DO_WGU), 128, 256, 0, r, scr, F_LANE); continue; } r -= I8;
        if (r < I8) { cvt_item(a.in[21] + (size_t)l * 1024 * FFN_H, FFN_H, 1024, 88, (u16*)(d + DO_WGU), 128, 256, 128, r, scr, F_LANE); continue; } r -= I8;
        cvt_item(a.in[22] + (size_t)l * FFN_H * 1024, 1024, FFN_H, 32, (u16*)(d + DO_WDN), BIG, 0, 0, r, scr, F_LANE);
    }
}

__device__ __forceinline__ void s5_mats(const Frame& F, const Args& a, int l) {
    float2* LP = (float2*)(F.lds);
    float2* BB = (float2*)(F.lds + 16384);
    float2* CC = (float2*)(F.lds + 32768);
    float* KT = (float*)(F.lds + 49152);
    u16* TM = (u16*)(F.dout + DO_TM); u16* EM = (u16*)(F.dout + DO_EM); float2* LAM = (float2*)(F.dout + DO_LAM);
    const int tid = F_TID;
    for (int unit = blockIdx.x; unit < 256; unit += F.G) {
        const int g = unit >> 3, part = unit & 7;
        __syncthreads();
        const float dt = __expf(a.in[7][l * 32 + g]);
        const float* lre = a.in[5] + (size_t)(l * 32 + g) * 64; const float* lim = a.in[6] + (size_t)(l * 32 + g) * 64;
        for (int e = tid; e < 17 * 64; e += 512) { const int tau = e >> 6, p = e & 63; const float mg = expf(lre[p] * dt * (float)tau); float sn, cs; sincosf(lim[p] * dt * (float)tau, &sn, &cs); LP[e] = make_float2(mg * cs, mg * sn); }
        for (int e = tid; e < 1024; e += 512) { const int p = e >> 4;
            const float lr = lre[p], li = lim[p]; const float mg = expf(lr * dt); float sn, cs; sincosf(li * dt, &sn, &cs);
            const float nr = mg * cs - 1.f, ni = mg * sn, den = 1.f / (lr * lr + li * li);
            const float qr = (nr * lr + ni * li) * den, qi = (ni * lr - nr * li) * den;
            const size_t bi = ((size_t)(l * 32 + g) * 64 + p) * 16 + (e & 15);
            const float br = a.in[8][bi], bim = a.in[9][bi];
            BB[e] = make_float2(qr * br - qi * bim, qr * bim + qi * br);
            const size_t ci = (size_t)(l * 32 + g) * 1024 + e;
            CC[e] = make_float2(a.in[10][ci], a.in[11][ci]); }
        __syncthreads();
        for (int e = tid; e < 4096; e += 512) { const int tau = e >> 8, hp = (e >> 4) & 15, h = e & 15; float s = 0.f;
            for (int p = 0; p < 64; ++p) { const float2 c = CC[hp * 64 + p], w = LP[tau * 64 + p], b = BB[p * 16 + h];
                const float wr_ = c.x * w.x - c.y * w.y, wi_ = c.x * w.y + c.y * w.x; s += wr_ * b.x - wi_ * b.y; }
            if (tau == 0 && hp == h) s += a.in[12][(size_t)(l * 32 + g) * 16 + h];
            KT[e] = s; }
        __syncthreads();
        for (int e = tid; e < 32 * 384; e += 512) { const int rr = e / 384, col = e - rr * 384; const int i = 2 * part + (rr >> 4), hp = rr & 15; float v;
            if (col < 256) { const int j = col >> 4, h = col & 15; v = (j <= i) ? KT[((i - j) * 16 + hp) * 16 + h] : 0.f; }
            else { const int p = (col - 256) & 63; const float2 c = CC[hp * 64 + p], w = LP[(i + 1) * 64 + p]; v = (col < 320) ? (c.x * w.x - c.y * w.y) : -(c.x * w.y + c.y * w.x); }
            TM[((size_t)g * 256 + i * 16 + hp) * 384 + col] = (u16)f2bf(v); }
        for (int e = tid; e < 16 * 256; e += 512) { const int r = 16 * part + (e >> 8), col = e & 255, j = col >> 4, h = col & 15, p = r & 63;
            const float2 w = LP[(15 - j) * 64 + p], b = BB[p * 16 + h];
            const float v = (r < 64) ? (w.x * b.x - w.y * b.y) : (w.x * b.y + w.y * b.x);
            EM[((size_t)g * 128 + r) * 256 + col] = (u16)f2bf(v); }
        if (part == 0 && tid < 64) LAM[g * 64 + tid] = LP[16 * 64 + tid];
    }
    __syncthreads();
}

template <int MODE> __device__ __forceinline__ void row_pass(const Frame& F, const Args& a, int l) {
    float* wfx = (float*)(F.lds + 131072 - 32768);
    const float* g = nullptr; const float* bb = nullptr;
    if (MODE == 1) { g = a.in[18] + l * 1024; bb = a.in[19] + l * 1024; }
    if (MODE >= 2) { g = a.in[23] + l * 1024; bb = a.in[24] + l * 1024; }
    if (MODE == 0 || MODE == 2) {
        const float* win = a.in[1] + (size_t)(MODE == 0 ? 0 : l + 1) * DMOD * INTOT + 3584;
        __syncthreads();
        for (int e = F_TID; e < 8192; e += 512) { const int k = e >> 3, j = e & 7; wfx[j * 1024 + k] = win[(size_t)k * INTOT + j]; }
        __syncthreads();
    }
    const float* src = (MODE == 0) ? a.in[0] : (const float*)(F.ws + WS_PRE);
    const int gw = F.vcu * 8 + F_WAVE, NGW = F.G * 8;
    for (int m = gw; m < M; m += NGW) {
        const f32x4* xr = (const f32x4*)(src + (size_t)m * 1024) + F_LANE;
        f32x4 v[4];
#pragma unroll
        for (int j = 0; j < 4; ++j) v[j] = xr[64 * j];
        if (MODE != 0) {
            float s = 0.f;
#pragma unroll
            for (int j = 0; j < 4; ++j) s += (v[j].x + v[j].y) + (v[j].z + v[j].w);
            const float mean = wave_sum(s) * (1.f / 1024.f); float s2 = 0.f;
#pragma unroll
            for (int j = 0; j < 4; ++j) { v[j] = v[j] - mean; s2 += (v[j].x * v[j].x + v[j].y * v[j].y) + (v[j].z * v[j].z + v[j].w * v[j].w); }
            const float rstd = 1.f / sqrtf(wave_sum(s2) * (1.f / 1024.f) + LN_EPS);
#pragma unroll
            for (int j = 0; j < 4; ++j) { const f32x4 gg = ((const f32x4*)g)[64 * j + F_LANE], bv = ((const f32x4*)bb)[64 * j + F_LANE]; v[j] = v[j] * rstd * gg + bv; }
        }
        if (MODE == 1) {
            f32x4* o = (f32x4*)(F.ws + WS_PRE + (size_t)m * 4096) + F_LANE;
#pragma unroll
            for (int j = 0; j < 4; ++j) o[64 * j] = v[j];
            v2u* ob = (v2u*)(F.ws + WS_H1B + (size_t)m * 2048) + F_LANE;
#pragma unroll
            for (int j = 0; j < 4; ++j) { v2u w; w.x = pk2(v[j].x, v[j].y); w.y = pk2(v[j].z, v[j].w); ob[64 * j] = w; }
        } else if (MODE == 3) {
            f32x4* o = (f32x4*)(a.out + (size_t)m * 1024) + F_LANE;
#pragma unroll
            for (int j = 0; j < 4; ++j) o[64 * j] = v[j];
        } else {
            v2u* ob = (v2u*)(F.ws + WS_HB + (size_t)m * 2048) + F_LANE;
            v2u* ol = (v2u*)(F.ws + WS_HBL + (size_t)m * 2048) + F_LANE;
#pragma unroll
            for (int j = 0; j < 4; ++j) { v2u w; w.x = pk2(v[j].x, v[j].y); w.y = pk2(v[j].z, v[j].w); ob[64 * j] = w;
                if (MODE == 2) { v2u wl; wl.x = pk2(v[j].x - bflo(w.x), v[j].y - bfhi(w.x)); wl.y = pk2(v[j].z - bflo(w.y), v[j].w - bfhi(w.y)); ol[64 * j] = wl; } }
            float mine = 0.f;
#pragma unroll 1
            for (int c = 0; c < 8; ++c) { float s = 0.f;
#pragma unroll
                for (int j = 0; j < 4; ++j) { const f32x4 w = *(const f32x4*)(wfx + c * 1024 + 256 * j + 4 * F_LANE); s += (v[j].x * w.x + v[j].y * w.y) + (v[j].z * w.z + v[j].w * w.w); }
                s = wave_sum(s); if (F_LANE == c) mine = s; }
            if (F_LANE < 8) ((float*)(F.ws + WS_MISC + MISC_FXF))[(size_t)m * 8 + F_LANE] = mine;
        }
    }
}

template <int MT, int NT> __device__ __forceinline__ void mma_lds(f32x4 (&acc)[MT][NT], const u16* sA, int lda, const u16* sB, int ldb, int K, int lane) {
    const int r = lane & 15, q = lane >> 4;
    for (int k0 = 0; k0 < K; k0 += 32) {
        bf16x8 av[MT], bv[NT];
#pragma unroll
        for (int mt = 0; mt < MT; ++mt) av[mt] = *(const bf16x8*)(sA + (mt * 16 + r) * lda + k0 + q * 8);
#pragma unroll
        for (int nt = 0; nt < NT; ++nt) bv[nt] = *(const bf16x8*)(sB + (nt * 16 + r) * ldb + k0 + q * 8);
#pragma unroll
        for (int mt = 0; mt < MT; ++mt)
#pragma unroll
            for (int nt = 0; nt < NT; ++nt) acc[mt][nt] = __builtin_amdgcn_mfma_f32_16x16x32_bf16(av[mt], bv[nt], acc[mt][nt], 0, 0, 0);
    }
}

__device__ __forceinline__ void hgrn_load_scan(const float* ZF, int row0, int h, float* LG, float* KK, float* QT, int tid) {
    for (int idx = tid; idx < 64 * 32; idx += 512) { const int t = idx >> 5, k4 = (idx & 31) * 4;
        const f32x4 lf = *(const f32x4*)(ZF + (size_t)(row0 + t) * 512 + h * 128 + k4);
        *(f32x4*)(LG + t * 128 + k4) = lf;
        f32x4 kk; kk[0] = 1.f - __expf(lf[0]); kk[1] = 1.f - __expf(lf[1]); kk[2] = 1.f - __expf(lf[2]); kk[3] = 1.f - __expf(lf[3]);
        *(f32x4*)(KK + t * 128 + k4) = kk; }
    __syncthreads();
    const int k = tid & 127, q = tid >> 7; float run = 0.f;
    for (int t = 16 * q; t < 16 * q + 16; ++t) { run += LG[t * 128 + k]; LG[t * 128 + k] = run; }
    QT[q * 128 + k] = run;
    __syncthreads();
}
__device__ __forceinline__ void load_vT(const u16* ZI, int row0, int h, u16* BT, int tid) {
    for (int idx = tid; idx < 1024; idx += 512) { const int s = idx & 63, v8 = (idx >> 6) * 8;
        const v4u e = *(const v4u*)(ZI + (size_t)(row0 + s) * 512 + h * 128 + v8);
        BT[(v8 + 0) * 72 + s] = (u16)(e.x & 0xffff); BT[(v8 + 1) * 72 + s] = (u16)(e.x >> 16); BT[(v8 + 2) * 72 + s] = (u16)(e.y & 0xffff); BT[(v8 + 3) * 72 + s] = (u16)(e.y >> 16);
        BT[(v8 + 4) * 72 + s] = (u16)(e.z & 0xffff); BT[(v8 + 5) * 72 + s] = (u16)(e.z >> 16); BT[(v8 + 6) * 72 + s] = (u16)(e.w & 0xffff); BT[(v8 + 7) * 72 + s] = (u16)(e.w >> 16); }
}
__device__ __forceinline__ void hgrn_a_unit(const Frame& F, int u) {
    const int b = u >> 7, h = (u >> 5) & 3, c = u & 31, row0 = b * SEQL + c * 64, tid = F_TID, lane = F_LANE, w = F_WAVE;
    float* LG = (float*)F.lds; float* KK = (float*)(F.lds + 32768); float* QT = (float*)(F.lds + 65536);
    u16* AT = (u16*)(F.lds + 67584); u16* BT = (u16*)(F.lds + 67584 + 18432);
    hgrn_load_scan((const float*)(F.ws + WS_ZF), row0, h, LG, KK, QT, tid);
    load_vT((const u16*)(F.ws + WS_ZI), row0, h, BT, tid);
    { const int k = tid & 127, q = tid >> 7; float off = 0.f, glast = 0.f;
#pragma unroll
      for (int qq = 0; qq < 4; ++qq) { const float t_ = QT[qq * 128 + k]; glast += t_; if (qq < q) off += t_; }
      for (int s = 16 * q; s < 16 * q + 16; ++s) { const float gg = LG[s * 128 + k] + off; AT[k * 72 + s] = (u16)f2bf(KK[s * 128 + k] * __expf(glast - gg)); }
      if (q == 0) ((float*)(F.ws + WS_MISC + MISC_DEC))[u * 128 + k] = __expf(glast); }
    __syncthreads();
    f32x4 acc[2][4];
#pragma unroll
    for (int i = 0; i < 2; ++i)
#pragma unroll
        for (int j = 0; j < 4; ++j) acc[i][j] = (f32x4){0.f, 0.f, 0.f, 0.f};
    mma_lds<2, 4>(acc, AT + ((w >> 1) * 32) * 72, 72, BT + ((w & 1) * 64) * 72, 72, 64, lane);
    u16* KV = (u16*)(F.ws + WS_KV) + (size_t)u * 16384;
#pragma unroll
    for (int mt = 0; mt < 2; ++mt)
#pragma unroll
        for (int nt = 0; nt < 4; ++nt) { const int k0 = (w >> 1) * 32 + mt * 16 + (lane >> 4) * 4, v = (w & 1) * 64 + nt * 16 + (lane & 15);
            v2u o; o.x = pk2(acc[mt][nt][0], acc[mt][nt][1]); o.y = pk2(acc[mt][nt][2], acc[mt][nt][3]); *(v2u*)(KV + v * 128 + k0) = o; }
    __syncthreads();
}
__device__ __forceinline__ void hgrn_scan(const Frame& F) {
    const float* DEC = (const float*)(F.ws + WS_MISC + MISC_DEC);
    for (int gid = blockIdx.x * 512 + F_TID; gid < 32 * 4096; gid += F.G * 512) {
        const int bh = gid >> 12, e = (gid & 4095) * 4, k = e & 127;
        float s0 = 0.f, s1 = 0.f, s2 = 0.f, s3 = 0.f;
        u16* p = (u16*)(F.ws + WS_KV) + (size_t)bh * 32 * 16384 + e;
        const float* dp = DEC + (size_t)bh * 32 * 128 + k;
#pragma unroll 4
        for (int c = 0; c < 32; ++c) { const v2u kv = *(const v2u*)(p + (size_t)c * 16384); const f32x4 d = *(const f32x4*)(dp + c * 128);
            v2u o; o.x = pk2(s0, s1); o.y = pk2(s2, s3); *(v2u*)(p + (size_t)c * 16384) = o;
            s0 = d[0] * s0 + bflo(kv.x); s1 = d[1] * s1 + bfhi(kv.x); s2 = d[2] * s2 + bflo(kv.y); s3 = d[3] * s3 + bfhi(kv.y); }
    }
}
__device__ __forceinline__ void hgrn_c_unit(const Frame& F, const Args& a, int l, int u) {
    const int b = u >> 7, h = (u >> 5) & 3, c = u & 31, row0 = b * SEQL + c * 64, tid = F_TID, lane = F_LANE, w = F_WAVE;
    float* LG = (float*)F.lds; float* KK = (float*)(F.lds + 32768); float* QT = (float*)(F.lds + 65536);
    u16* ST = (u16*)F.lds; u16* BT = (u16*)(F.lds + 34816); u16* PP = (u16*)(F.lds + 53248);
    u16* QE = (u16*)(F.lds + 67584); u16* KE = (u16*)(F.lds + 84992); float* RS = (float*)(F.lds + 102400);
    hgrn_load_scan((const float*)(F.ws + WS_ZF), row0, h, LG, KK, QT, tid);
    { const int k = tid & 127, q = tid >> 7; float off = 0.f;
#pragma unroll
      for (int qq = 0; qq < 4; ++qq) { const float t_ = QT[qq * 128 + k]; if (qq < q) off += t_; }
      const u16* ZQ = (const u16*)(F.ws + WS_ZQ) + (size_t)row0 * 512 + h * 128 + k;
      for (int t = 16 * q; t < 16 * q + 16; ++t) { const float gg = LG[t * 128 + k] + off; const float qv = bf2f(ZQ[(size_t)t * 512]);
          QE[t * 136 + k] = (u16)f2bf(qv * __expf(gg)); KE[t * 136 + k] = (u16)f2bf(KK[t * 128 + k] * __expf(fminf(-gg, 80.f))); } }
    __syncthreads();
    { const u16* KV = (const u16*)(F.ws + WS_KV) + (size_t)u * 16384;
      for (int idx = tid; idx < 2048; idx += 512) { const int v = idx >> 4, k8 = (idx & 15) * 8; *(v4u*)(ST + v * 136 + k8) = *(const v4u*)(KV + v * 128 + k8); } }
    load_vT((const u16*)(F.ws + WS_ZI), row0, h, BT, tid);
    const int mt = w >> 1;
    { f32x4 sc[1][2]; sc[0][0] = (f32x4){0.f, 0.f, 0.f, 0.f}; sc[0][1] = (f32x4){0.f, 0.f, 0.f, 0.f};
      const int nt0 = (w & 1) * 2;
      mma_lds<1, 2>(sc, QE + mt * 16 * 136, 136, KE + nt0 * 16 * 136, 136, 128, lane);
#pragma unroll
      for (int i = 0; i < 2; ++i)
#pragma unroll
          for (int j = 0; j < 4; ++j) { const int t = mt * 16 + (lane >> 4) * 4 + j, s = (nt0 + i) * 16 + (lane & 15); PP[t * 72 + s] = (u16)f2bf(s <= t ? sc[0][i][j] : 0.f); } }
    __syncthreads();
    f32x4 acc[1][4];
#pragma unroll
    for (int i = 0; i < 4; ++i) acc[0][i] = (f32x4){0.f, 0.f, 0.f, 0.f};
    mma_lds<1, 4>(acc, QE + mt * 16 * 136, 136, ST + ((w & 1) * 64) * 136, 136, 128, lane);
    mma_lds<1, 4>(acc, PP + mt * 16 * 72, 72, BT + ((w & 1) * 64) * 72, 72, 64, lane);
#pragma unroll
    for (int j = 0; j < 4; ++j) { float ss = 0.f;
#pragma unroll
        for (int i = 0; i < 4; ++i) ss += acc[0][i][j] * acc[0][i][j];
        ss += __shfl_xor(ss, 1); ss += __shfl_xor(ss, 2); ss += __shfl_xor(ss, 4); ss += __shfl_xor(ss, 8);
        if ((lane & 15) == 0) RS[(mt * 16 + (lane >> 4) * 4 + j) * 2 + (w & 1)] = ss; }
    __syncthreads();
    const float* nw = a.in[3] + l * 128;
#pragma unroll
    for (int j = 0; j < 4; ++j) { const int t = mt * 16 + (lane >> 4) * 4 + j; const float r = rsqrtf((RS[t * 2] + RS[t * 2 + 1]) * (1.f / 128.f) + RMS_EPS);
        const size_t ro = (size_t)(row0 + t) * 512 + h * 128;
#pragma unroll
        for (int i = 0; i < 4; ++i) { const int v = (w & 1) * 64 + i * 16 + (lane & 15); const float gt = bf2f(((const u16*)(F.ws + WS_ZG))[ro + v]);
            ((u16*)(F.ws + WS_YA))[ro + v] = (u16)f2bf(acc[0][i][j] * r * nw[v] * gt * sigm(gt)); } }
    __syncthreads();
}

__device__ __forceinline__ void load_tile16(u16* dst, int dpitch, const u16* src, size_t spitch, int rows, int cols8, int tid) {
    for (int idx = tid; idx < rows * cols8; idx += 512) { const int r = idx / cols8, c8 = idx - r * cols8; *(v4u*)(dst + r * dpitch + c8 * 8) = *(const v4u*)(src + (size_t)r * spitch + c8 * 8); }
}
__device__ __forceinline__ void s5_1_unit(const Frame& F, int unit) {
    const int g = unit >> 3, rt = unit & 7, tid = F_TID, lane = F_LANE, w = F_WAVE;
    u16* A = (u16*)F.lds; u16* B = (u16*)(F.lds + 67584);
    load_tile16(A, 264, (const u16*)(F.ws + WS_SU) + ((size_t)g * 1024 + rt * 128) * 256, 256, 128, 32, tid);
    load_tile16(B, 264, (const u16*)(F.dout + DO_EM) + (size_t)g * 128 * 256, 256, 128, 32, tid);
    __syncthreads();
    f32x4 acc[2][4];
#pragma unroll
    for (int i = 0; i < 2; ++i)
#pragma unroll
        for (int j = 0; j < 4; ++j) acc[i][j] = (f32x4){0.f, 0.f, 0.f, 0.f};
    mma_lds<2, 4>(acc, A + ((w >> 1) * 32) * 264, 264, B + ((w & 1) * 64) * 264, 264, 256, lane);
    u16* SE = (u16*)(F.ws + WS_SE);
#pragma unroll
    for (int mt = 0; mt < 2; ++mt)
#pragma unroll
        for (int nt = 0; nt < 4; ++nt)
#pragma unroll
            for (int j = 0; j < 4; ++j) { const int n = rt * 128 + (w >> 1) * 32 + mt * 16 + (lane >> 4) * 4 + j, r = (w & 1) * 64 + nt * 16 + (lane & 15);
                SE[((size_t)n * 32 + g) * 128 + r] = (u16)f2bf(acc[mt][nt][j]); }
    __syncthreads();
}
__device__ __forceinline__ void s5_scan(const Frame& F) {
    if (F_WAVE != 0) return;
    const float2* LAM = (const float2*)(F.dout + DO_LAM);
    for (int gl = blockIdx.x * 64 + F_LANE; gl < 8 * 32 * 64; gl += F.G * 64) {
        const int b = gl >> 11, g = (gl >> 6) & 31, p = gl & 63; const float2 lm = LAM[g * 64 + p];
        u16* base = (u16*)(F.ws + WS_SE) + ((size_t)(b * 128) * 32 + g) * 128 + p;
        float sr = 0.f, si = 0.f;
        for (int c0 = 0; c0 < 128; c0 += 8) {
            float er[8], ei[8];
#pragma unroll
            for (int i = 0; i < 8; ++i) { const u16* q = base + (size_t)(c0 + i) * 4096; er[i] = bf2f(q[0]); ei[i] = bf2f(q[64]); }
#pragma unroll
            for (int i = 0; i < 8; ++i) { u16* q = base + (size_t)(c0 + i) * 4096; q[0] = (u16)f2bf(sr); q[64] = (u16)f2bf(si);
                const float nr = lm.x * sr - lm.y * si + er[i], ni = lm.x * si + lm.y * sr + ei[i]; sr = nr; si = ni; }
        }
    }
}
__device__ __forceinline__ void s5_2_unit(const Frame& F, int unit) {
    const int g = unit >> 3, rt = unit & 7, tid = F_TID, lane = F_LANE, w = F_WAVE;
    u16* A = (u16*)F.lds; u16* B = (u16*)(F.lds + 34816);
    f32x4 acc[2][8];
#pragma unroll
    for (int i = 0; i < 2; ++i)
#pragma unroll
        for (int j = 0; j < 8; ++j) acc[i][j] = (f32x4){0.f, 0.f, 0.f, 0.f};
    for (int kc = 0; kc < 3; ++kc) {
        __syncthreads();
        if (kc < 2) load_tile16(A, 136, (const u16*)(F.ws + WS_SU) + ((size_t)g * 1024 + rt * 128) * 256 + kc * 128, 256, 128, 16, tid);
        else        load_tile16(A, 136, (const u16*)(F.ws + WS_SE) + ((size_t)(rt * 128) * 32 + g) * 128, 4096, 128, 16, tid);
        load_tile16(B, 136, (const u16*)(F.dout + DO_TM) + (size_t)g * 256 * 384 + kc * 128, 384, 256, 16, tid);
        __syncthreads();
        mma_lds<2, 8>(acc, A + ((w >> 1) * 32) * 136, 136, B + ((w & 1) * 128) * 136, 136, 128, lane);
    }
    u16* YG = (u16*)(F.dout + DO_YG);
#pragma unroll
    for (int mt = 0; mt < 2; ++mt)
#pragma unroll
        for (int nt = 0; nt < 8; ++nt)
#pragma unroll
            for (int j = 0; j < 4; ++j) { const int n = rt * 128 + (w >> 1) * 32 + mt * 16 + (lane >> 4) * 4 + j, i = (w & 1) * 8 + nt, hp = lane & 15;
                const float y = acc[mt][nt][j]; const float z = 0.7978845608028654f * (y + 0.044715f * y * y * y);
                const float th = 1.f - 2.f / (__expf(2.f * z) + 1.f);
                YG[((size_t)n * 16 + i) * 512 + 16 * g + hp] = (u16)f2bf(0.5f * y * (1.f + th)); }
    __syncthreads();
}

__global__ void __launch_bounds__(512, 2) mega_fwd(Args a) {
    extern __shared__ __attribute__((aligned(16))) unsigned char lds[];
    cg::grid_group grid = cg::this_grid();
    Frame F; F.lds = lds; F.ws = a.ws; F.dout = (unsigned char*)a.out;
    F.G = gridDim.x; { const int bx = blockIdx.x; F.vcu = (F.G % 8 == 0) ? (bx % 8) * (F.G / 8) + bx / 8 : bx; }
    PG8_LAS unsigned char* glds = (PG8_LAS unsigned char*)lds;
    typedef pg8::bf16_t pb;
    unsigned char* ws = a.ws; unsigned char* dq = F.dout;

    if (blockIdx.x == 0) { float* LB = (float*)(ws + WS_MISC + MISC_LB);
        for (int k = F_TID; k < 512; k += 512) { const float a0 = a.in[2][k], a1 = a.in[2][512 + k], mx = fmaxf(a0, a1), e0 = expf(a0 - mx), e1 = expf(a1 - mx); LB[k] = 0.f; LB[512 + k] = e1 / (e0 + e1); } }
#ifndef NO_PRO
    convert_weights(F, a, 0);
    s5_mats(F, a, 0);
#endif
#ifndef NO_ROW
    row_pass<0>(F, a, 0);
#endif
    grid.sync();

    for (int l = 0; l < 2; ++l) {
#ifndef NO_GEMM
        { pg8::Gemm g{(const pb*)(ws + WS_HB), (const pb*)(dq + DO_WIN), M, 4096, 1024}; pg8::StaticOrder S; S.init(M, 4096, F.G, (int)blockIdx.x);
          pg8::EpiIn E{ws, (const float*)(ws + WS_MISC + MISC_LB) + l * 512, attn_body::C2};
          pg8::gemm_phase<pg8::EpiIn, pg8::StaticOrder, true, true>(glds, g, S, E); }
#endif
        grid.sync();
#ifndef NO_ATTN
        { const attn_body::AttnTensors AT{(const attn_body::bf16*)(ws + WS_FQ), (const attn_body::bf16*)(ws + WS_FK), (const attn_body::bf16*)(ws + WS_FV), (attn_body::bf16*)(ws + WS_YB),
                                          (const float*)(ws + WS_MISC + MISC_FXF), a.in[4] + l * 8};
          const attn_body::StaticOrder S((int)F.G, (int)blockIdx.x);
          attn_body::attn_phase<attn_body::StaticOrder>((char*)lds, AT, S); }
#endif
        __syncthreads();
#ifndef NO_MIX
        for (int u = F.vcu; u < 1024; u += F.G) hgrn_a_unit(F, u);
        for (int u = F.vcu; u < 256; u += F.G) s5_1_unit(F, u);
#endif
        grid.sync();
#ifndef NO_MIX
        hgrn_scan(F);
        s5_scan(F);
#endif
        grid.sync();
#ifndef NO_MIX
        for (int u = F.vcu; u < 1024; u += F.G) hgrn_c_unit(F, a, l, u);
        for (int u = F.vcu; u < 256; u += F.G) s5_2_unit(F, u);
#endif
        grid.sync();
#ifndef NO_GEMM2
        { pg8::Gemm g{(const pb*)(dq + DO_YG), (const pb*)(dq + DO_WGLU), M, 512, 512}; pg8::StaticOrder S; S.init(M, 512, F.G, (int)blockIdx.x);
          pg8::EpiGlu E{(const pb*)(dq + DO_YG), (pb*)(ws + WS_YC)};
          pg8::gemm_phase<pg8::EpiGlu, pg8::StaticOrder, true, true>(glds, g, S, E); }
        { pg8::Gemm g{(const pb*)(ws + WS_HB), (const pb*)(dq + DO_WIN) + (size_t)4096 * 1024, M, 3072, 1024}; pg8::StaticOrder S; S.init(M, 3072, F.G, (int)blockIdx.x);
          pg8::EpiGate E{(pb*)(ws + WS_GATES)};
          pg8::gemm_phase<pg8::EpiGate, pg8::StaticOrder, true, true>(glds, g, S, E); }
        grid.sync();
        { pg8::Gemm g{(const pb*)(ws + WS_YA), (const pb*)(dq + DO_WBR), 3 * M, 3072, 512}; pg8::BranchOrder S; S.init(F.G, (int)blockIdx.x);
          pg8::EpiBranch E{(const pb*)(ws + WS_GATES), (pb*)(ws + WS_MERGED)};
          pg8::gemm_phase<pg8::EpiBranch, pg8::BranchOrder, true, true>(glds, g, S, E); }
        grid.sync();
        { pg8::Gemm g{(const pb*)(ws + WS_MERGED), (const pb*)(dq + DO_WOUT), M, 1024, 1024}; pg8::StaticOrder S; S.init(M, 1024, F.G, (int)blockIdx.x);
          pg8::EpiRes E{l == 0 ? a.in[0] : nullptr, (const pb*)(ws + WS_HB), (const pb*)(ws + WS_HBL), (float*)(ws + WS_PRE)};
          pg8::gemm_phase<pg8::EpiRes, pg8::StaticOrder, true, true>(glds, g, S, E); }
        grid.sync();
#endif
#ifndef NO_ROW
        row_pass<1>(F, a, l);
#endif
        grid.sync();
#ifndef NO_GEMM3
        { pg8::Gemm g{(const pb*)(ws + WS_H1B), (const pb*)(dq + DO_WGU), M, 5632, 1024}; pg8::StaticOrder S; S.init(M, 5632, F.G, (int)blockIdx.x);
          pg8::EpiSwiglu E{(pb*)(ws + WS_FFH)};
          pg8::gemm_phase<pg8::EpiSwiglu, pg8::StaticOrder, true, true>(glds, g, S, E); }
        grid.sync();
        { pg8::Gemm g{(const pb*)(ws + WS_FFH), (const pb*)(dq + DO_WDN), M, 1024, FFN_H}; pg8::StaticOrder S; S.init(M, 1024, F.G, (int)blockIdx.x);
          pg8::EpiRes E{(const float*)(ws + WS_PRE), nullptr, nullptr, (float*)(ws + WS_PRE)};
          pg8::gemm_phase<pg8::EpiRes, pg8::StaticOrder, true, true>(glds, g, S, E); }
        grid.sync();
#endif
        if (l == 0) {
#ifndef NO_PRO
            convert_weights(F, a, 1); s5_mats(F, a, 1);
#endif
#ifndef NO_ROW
            row_pass<2>(F, a, 0);
#endif
            grid.sync(); }
#ifndef NO_ROW
        else row_pass<3>(F, a, 1);
#endif
    }
}

extern "C" void kernel_launch(void* const* d_in, const int* in_sizes, int n_in, void* d_out, int out_size, void* d_ws, size_t ws_size, hipStream_t stream) {
    static int grid = 0;
    if (grid == 0) {
        int dev = 0, cus = 0, per_cu = 0;
        if (hipGetDevice(&dev) != hipSuccess || hipDeviceGetAttribute(&cus, hipDeviceAttributeMultiprocessorCount, dev) != hipSuccess) { fprintf(stderr, "kernel_launch: device query failed\n"); grid = -1; return; }
        if (hipFuncSetAttribute((const void*)mega_fwd, hipFuncAttributeMaxDynamicSharedMemorySize, LDS_BYTES) != hipSuccess) { fprintf(stderr, "kernel_launch: hipFuncSetAttribute failed\n"); grid = -1; return; }
        if (hipOccupancyMaxActiveBlocksPerMultiprocessor(&per_cu, (const void*)mega_fwd, 512, LDS_BYTES) != hipSuccess || per_cu < 1) { fprintf(stderr, "kernel_launch: occupancy query says %d blocks per CU\n", per_cu); grid = -1; return; }
        grid = cus;
        if (n_in != 25 || out_size != M * DMOD || ws_size < 256 * MiB) { fprintf(stderr, "kernel_launch: unexpected shapes (n_in %d out %d ws %zu)\n", n_in, out_size, ws_size); grid = -1; return; }
    }
    if (grid < 0) return;
    Args a{};
    for (int i = 0; i < 25; ++i) a.in[i] = (const float*)d_in[i];
    a.out = (float*)d_out; a.ws = (unsigned char*)d_ws;
    void* args[] = {&a};
    hipError_t e = hipLaunchCooperativeKernel((void*)mega_fwd, dim3(grid), dim3(512), args, LDS_BYTES, stream);
    if (e != hipSuccess) fprintf(stderr, "kernel_launch: cooperative launch failed: %s (grid %d)\n", hipGetErrorString(e), grid);
}
```

```cpp
#include <hip/hip_runtime.h>
#include <hip/hip_cooperative_groups.h>
#include <cstdio>
#include <cstdint>
namespace cg = cooperative_groups;

namespace pg8 {
#define PG8_LAS __attribute__((address_space(3)))
typedef unsigned short bf16_t;
typedef short bf16x8 __attribute__((ext_vector_type(8)));
typedef float f32x4 __attribute__((ext_vector_type(4)));
typedef unsigned u32x4 __attribute__((ext_vector_type(4)));
constexpr int BM = 256, BK = 64, HALF = 128, HTB = HALF * BK * 2  , STAGE_BYTES = 8 * HTB, NXCD = 8, WGM = 8;

__host__ __device__ __forceinline__ int lds_byte(int r, int c) { const int st = (r >> 4) * 2 + (c >> 5), rr = r & 15, cc = c & 31, ob = rr * 64 + cc * 2; return st * 1024 + (ob ^ (((ob >> 9) & 1) << 5)); }
__host__ __device__ __forceinline__ void stage_rc(int b, int& R, int& C) { const int st = b / 1024, sb = b % 1024, swz = sb ^ (((sb >> 9) & 1) << 5); R = (st >> 1) * 16 + swz / 64; C = (st & 1) * 32 + (swz % 64) / 2; }
__host__ __device__ __forceinline__ int perm32(int rho) { const int n = rho >> 4, i = rho & 15; return 8 * (i >> 2) + 4 * n + (i & 3); }

struct Unit { int pm, pn; };
struct Gemm { const bf16_t* A; const bf16_t* Bt; int M, N, K; };

struct StaticOrder {
    int nM, nN, nwg, G, c;
    __host__ __device__ void init(int M, int N, int G_, int c_) { nM = M / BM; nN = N / BM; nwg = nM * nN; G = G_; c = c_; }
    __host__ __device__ bool next(int i, Unit& u) const {
        const long L = (long)i * G + c; if (L >= nwg) return false;
        int wgid = (int)L; { const int q = nwg / NXCD, r = nwg % NXCD, xcd = wgid % NXCD, off = wgid / NXCD; wgid = (xcd < r ? xcd * (q + 1) : r * (q + 1) + (xcd - r) * q) + off; }
        const int nig = WGM * nN, gid = wgid / nig, fm = gid * WGM, gsz = (nM - fm) < WGM ? (nM - fm) : WGM;
        u.pm = fm + ((wgid % nig) % gsz); u.pn = (wgid % nig) / gsz; return true;
    }
    __device__ __forceinline__ void a_ready(const Unit&) const {}
    __device__ __forceinline__ void done(const Unit&) const {}
};

__device__ __forceinline__ unsigned cvt_pk_bf16(float lo, float hi) { unsigned r; asm volatile("v_cvt_pk_bf16_f32 %0, %1, %2" : "=v"(r) : "v"(lo), "v"(hi)); return r; }
typedef float f32x2 __attribute__((ext_vector_type(2)));

template <class Epi, class Sched, bool ALIGN_EPI = false, bool SP2 = false>
__device__ __forceinline__ void gemm_phase(PG8_LAS unsigned char* lds, const Gemm g, const Sched& S, const Epi& E) {
    int tid_o = threadIdx.x; asm volatile("" : "+v"(tid_o));
    const int tid = tid_o, wid = __builtin_amdgcn_readfirstlane(tid >> 6), lane = tid & 63, wr = wid >> 2, wc = wid & 3, fr = lane & 15, fq = lane >> 4;
    const int K = g.K, nt = K / BK;
    unsigned voffA[2], voffB[2];
#pragma unroll
    for (int i = 0; i < 2; ++i) { int R, C; stage_rc(tid * 16 + i * 8192, R, C); const int Rb = Epi::PERM ? ((R & ~31) + perm32(R & 31)) : R;
        voffA[i] = (unsigned)(R * K + C) * 2u; voffB[i] = (unsigned)(Rb * K + C) * 2u; }
    const size_t kstep = (size_t)(BK * 2);
    const size_t hstep = (size_t)HALF * K * 2;
    const size_t tstep = 2 * hstep;
    const unsigned ldsw = (unsigned)wid * 1024u;
    const int aoff = lds_byte(wr * 64 + fr, fq * 8), boff = lds_byte(wc * 32 + fr, fq * 8);
#define PG8_SA(b, h) (((b) * 2 + (h)) * HTB)
#define PG8_SB(b, h) ((4 + (b) * 2 + (h)) * HTB)
#define PG8_STAGE(bufoff, gbase, voff) do { _Pragma("unroll") for (int _i = 0; _i < 2; ++_i) \
        __builtin_amdgcn_global_load_lds((const unsigned*)((const char*)(gbase) + (voff)[_i]), (PG8_LAS unsigned*)(lds + (bufoff) + ldsw + _i * 8192), 16, 0, 0); } while (0)
#define PG8_LDA(dst, b, h) do { _Pragma("unroll") for (int m = 0; m < 4; ++m) _Pragma("unroll") for (int k = 0; k < 2; ++k) dst[m][k] = *(const PG8_LAS bf16x8*)(lds + PG8_SA(b, h) + aoff + m * 2048 + k * 1024); } while (0)
#define PG8_LDB(dst, b, h) do { _Pragma("unroll") for (int n = 0; n < 2; ++n) _Pragma("unroll") for (int k = 0; k < 2; ++k) dst[n][k] = *(const PG8_LAS bf16x8*)(lds + PG8_SB(b, h) + boff + n * 2048 + k * 1024); } while (0)
#define PG8_MMA(ai, bj, At, Bt) do { __builtin_amdgcn_s_setprio(1); _Pragma("unroll") for (int m = 0; m < 4; ++m) _Pragma("unroll") for (int n = 0; n < 2; ++n) _Pragma("unroll") for (int k = 0; k < 2; ++k) \
        acc[ai][bj][m][n] = __builtin_amdgcn_mfma_f32_16x16x32_bf16(Bt[n][k], At[m][k], acc[ai][bj][m][n], 0, 0, 0); __builtin_amdgcn_s_setprio(0); } while (0)
#define PG8_WAIT_V(n) asm volatile("s_waitcnt vmcnt(" #n ")" ::: "memory")
#define PG8_WAIT_L(n) asm volatile("s_waitcnt lgkmcnt(" #n ")" ::: "memory")
#define PG8_BAR __builtin_amdgcn_s_barrier()
#define PG8_SCHED __builtin_amdgcn_sched_barrier(0)
    Unit cur, nxt; int ui = 0;
    if (!S.next(0, cur)) return;
    f32x4 acc[2][2][4][2];
#pragma unroll
    for (int a = 0; a < 2; ++a)
#pragma unroll
        for (int b = 0; b < 2; ++b)
#pragma unroll
            for (int m = 0; m < 4; ++m)
#pragma unroll
                for (int n = 0; n < 2; ++n) acc[a][b][m][n] = (f32x4){0.f, 0.f, 0.f, 0.f};
    bf16x8 At[4][2], B0[2][2], B1[2][2];
    const char* cA = (const char*)g.A + (size_t)cur.pm * tstep; const char* cB = (const char*)g.Bt + (size_t)cur.pn * tstep;
    S.a_ready(cur);
    if constexpr (SP2) {
        PG8_STAGE(PG8_SB(0, 0), cB, voffB); PG8_STAGE(PG8_SB(0, 1), cB + hstep, voffB); PG8_STAGE(PG8_SA(0, 0), cA, voffA); PG8_STAGE(PG8_SA(0, 1), cA + hstep, voffA);
        if (wr == 1) PG8_BAR;
        PG8_WAIT_V(2); PG8_BAR;
        PG8_STAGE(PG8_SB(1, 0), cB + kstep, voffB); PG8_STAGE(PG8_SA(1, 0), cA + kstep, voffA); PG8_STAGE(PG8_SB(1, 1), cB + hstep + kstep, voffB);
        PG8_WAIT_V(6); PG8_BAR;
    } else {
        PG8_STAGE(PG8_SB(0, 0), cB, voffB); PG8_STAGE(PG8_SA(0, 0), cA, voffA); PG8_STAGE(PG8_SB(0, 1), cB + hstep, voffB); PG8_STAGE(PG8_SA(0, 1), cA + hstep, voffA);
        if (wr == 1) PG8_BAR;
        PG8_WAIT_V(4); PG8_BAR;
        PG8_STAGE(PG8_SB(1, 0), cB + kstep, voffB); PG8_STAGE(PG8_SA(1, 0), cA + kstep, voffA); PG8_STAGE(PG8_SB(1, 1), cB + hstep + kstep, voffB);
        PG8_WAIT_V(6); PG8_BAR;
    }
    for (;;) {
        const bool has_next = S.next(ui + 1, nxt);
        const char* nA = has_next ? (const char*)g.A + (size_t)nxt.pm * tstep : cA; const char* nB = has_next ? (const char*)g.Bt + (size_t)nxt.pn * tstep : cB;
        for (int t = 0; t < nt; t += 2) {
            const bool last = (t == nt - 2);
            const char* a1 = cA + (size_t)(t + 1) * kstep;
            const char* a2 = last ? nA : cA + (size_t)(t + 2) * kstep; const char* b2 = last ? nB : cB + (size_t)(t + 2) * kstep;
            const char* a3 = a2 + kstep; const char* b3 = b2 + kstep;
            if (last && has_next) S.a_ready(nxt);
            if constexpr (SP2) {
            PG8_LDB(B0, 0, 0); PG8_LDB(B1, 0, 1); PG8_SCHED; PG8_LDA(At, 0, 0); PG8_STAGE(PG8_SA(1, 1), a1 + hstep, voffA);
            PG8_WAIT_V(8); PG8_WAIT_L(0); PG8_BAR; PG8_MMA(0, 0, At, B0); PG8_MMA(0, 1, At, B1); PG8_BAR; PG8_SCHED;
            PG8_LDA(At, 0, 1); PG8_STAGE(PG8_SB(0, 0), b2, voffB); PG8_STAGE(PG8_SB(0, 1), b2 + hstep, voffB); PG8_STAGE(PG8_SA(0, 0), a2, voffA);
            PG8_WAIT_V(8); PG8_WAIT_L(0); PG8_BAR; PG8_MMA(1, 0, At, B0); PG8_MMA(1, 1, At, B1); PG8_BAR; PG8_SCHED;
            PG8_LDB(B0, 1, 0); PG8_LDB(B1, 1, 1); PG8_SCHED; PG8_LDA(At, 1, 0); PG8_STAGE(PG8_SA(0, 1), a2 + hstep, voffA);
            PG8_WAIT_V(8); PG8_WAIT_L(0); PG8_BAR; PG8_MMA(0, 0, At, B0); PG8_MMA(0, 1, At, B1); PG8_BAR; PG8_SCHED;
            PG8_LDA(At, 1, 1); PG8_STAGE(PG8_SB(1, 0), b3, voffB); PG8_STAGE(PG8_SB(1, 1), b3 + hstep, voffB); PG8_STAGE(PG8_SA(1, 0), a3, voffA);
            PG8_WAIT_V(8); PG8_WAIT_L(0); PG8_BAR; PG8_MMA(1, 0, At, B0); PG8_MMA(1, 1, At, B1); PG8_BAR; PG8_SCHED;
            } else {
            PG8_LDB(B0, 0, 0); PG8_SCHED; PG8_LDA(At, 0, 0); PG8_STAGE(PG8_SA(1, 1), a1 + hstep, voffA);
            PG8_WAIT_L(8); PG8_BAR; PG8_WAIT_L(0); PG8_MMA(0, 0, At, B0); PG8_BAR; PG8_SCHED;
            PG8_LDB(B1, 0, 1); PG8_STAGE(PG8_SB(0, 0), b2, voffB);
            PG8_BAR; PG8_WAIT_L(0); PG8_MMA(0, 1, At, B1); PG8_BAR;
            PG8_LDA(At, 0, 1); PG8_STAGE(PG8_SA(0, 0), a2, voffA);
            PG8_BAR; PG8_WAIT_L(0); PG8_MMA(1, 0, At, B0); PG8_BAR; PG8_SCHED;
            PG8_STAGE(PG8_SB(0, 1), b2 + hstep, voffB);
            PG8_WAIT_V(6); PG8_BAR; PG8_MMA(1, 1, At, B1); PG8_BAR;
            PG8_LDB(B0, 1, 0); PG8_SCHED; PG8_LDA(At, 1, 0); PG8_STAGE(PG8_SA(0, 1), a2 + hstep, voffA);
            PG8_WAIT_L(8); PG8_BAR; PG8_WAIT_L(0); PG8_MMA(0, 0, At, B0); PG8_BAR; PG8_SCHED;
            PG8_LDB(B1, 1, 1); PG8_STAGE(PG8_SB(1, 0), b3, voffB);
            PG8_BAR; PG8_WAIT_L(0); PG8_MMA(0, 1, At, B1); PG8_BAR;
            PG8_LDA(At, 1, 1); PG8_STAGE(PG8_SA(1, 0), a3, voffA);
            PG8_BAR; PG8_WAIT_L(0); PG8_MMA(1, 0, At, B0); PG8_BAR; PG8_SCHED;
            PG8_STAGE(PG8_SB(1, 1), b3 + hstep, voffB);
            PG8_WAIT_V(6); PG8_BAR; PG8_MMA(1, 1, At, B1); PG8_BAR;
            }
        }
        if constexpr (ALIGN_EPI) { if (wr == 0) PG8_BAR; }
        if constexpr (!Epi::AFTER_DRAIN) { E(acc, cur, wr, wc, fr, fq); S.done(cur); }
        if (!has_next) break;
        if constexpr (!Epi::KEEP_ACC) {
#pragma unroll
        for (int a = 0; a < 2; ++a)
#pragma unroll
            for (int b = 0; b < 2; ++b)
#pragma unroll
                for (int m = 0; m < 4; ++m)
#pragma unroll
                    for (int n = 0; n < 2; ++n) acc[a][b][m][n] = (f32x4){0.f, 0.f, 0.f, 0.f};
        }
        cur = nxt; cA = nA; cB = nB; ++ui;
        if constexpr (ALIGN_EPI) { if (wr == 1) PG8_BAR; }
    }
    PG8_WAIT_V(0);
    if constexpr (!ALIGN_EPI) { if (wr == 0) PG8_BAR; }
    PG8_BAR;
    if constexpr (Epi::AFTER_DRAIN) { E.fused(acc, cur, wr, wc, fr, fq, lds, wid, lane); S.done(cur); }
#undef PG8_SA
#undef PG8_SB
#undef PG8_STAGE
#undef PG8_LDA
#undef PG8_LDB
#undef PG8_MMA
#undef PG8_WAIT_V
#undef PG8_WAIT_L
#undef PG8_BAR
#undef PG8_SCHED
}
}
#include <hip/hip_bf16.h>
#include <cmath>
namespace attn_body {
using bf16=__hip_bfloat16;
using bf16x8=__attribute__((ext_vector_type(8)))short;
using s16x4=__attribute__((ext_vector_type(4)))short;
using f32x16=__attribute__((ext_vector_type(16)))float;
using u32x4=__attribute__((ext_vector_type(4)))unsigned;
using f32x4b=__attribute__((ext_vector_type(4)))float;
constexpr int BATCH=8,NHEAD=8,SEQ=2048,D=64,DM=NHEAD*D;
constexpr int NW=8,QBLK=32,QB=QBLK*NW,KVBLK=64,NQB=SEQ/QB;
constexpr int ATTN_PITCH=DM, ATTN_UNIT_ROWS=QB;
__device__ __forceinline__ int crow(int r,int hi){return (r&3)+8*(r>>2)+4*hi;}
#define SBAR() __builtin_amdgcn_sched_barrier(0)
__device__ __forceinline__ void cmask(f32x16&p0,f32x16&p1,int jb,int qrel,int hi){
  const float NEG=-INFINITY; int kb=64*jb+4*hi;
  #pragma unroll
  for(int r=0;r<16;++r){int kv=kb+(r&3)+8*(r>>2); if(kv>qrel)p0[r]=NEG; if(kv+32>qrel)p1[r]=NEG;}
}

constexpr int NSLOT=3, SLOTB=8192;
constexpr int LDS_K=0, LDS_V=NSLOT*SLOTB, LDS_WS=2*NSLOT*SLOTB, LDS_OST=LDS_WS+NW*64*4, LDS_BIAS=LDS_OST+NW*4096, LDS_SCAN=LDS_BIAS+SEQ*4, LDS_BYTES=LDS_SCAN+256;
constexpr float C2=0.125f*1.4426950408889634f;
__device__ __forceinline__ void glds16(const void*gsrc,unsigned lds_dst){unsigned keep;
  asm volatile("s_mov_b32 %0, m0\n\ts_mov_b32 m0, %2\n\ts_nop 0\n\tglobal_load_lds_dwordx4 %1, off\n\ts_mov_b32 m0, %0":"=&s"(keep):"v"(gsrc),"s"(lds_dst):"memory");}
__device__ __forceinline__ float max3f(float a,float b,float c){float r;asm("v_max3_f32 %0, %1, %2, %3":"=v"(r):"v"(a),"v"(b),"v"(c));return r;}
__device__ __forceinline__ float max2f(float a,float b){float r;asm("v_max_f32_e32 %0, %1, %2":"=v"(r):"v"(a),"v"(b));return r;}
__device__ __forceinline__ float fadd_s(float a,float b){float r;asm("v_add_f32_e32 %0, %1, %2":"=v"(r):"v"(a),"v"(b));return r;}
__device__ __forceinline__ float fsub_s(float a,float b){float r;asm("v_sub_f32_e32 %0, %1, %2":"=v"(r):"v"(a),"v"(b));return r;}
typedef float f32x2_t __attribute__((ext_vector_type(2))); typedef __bf16 bf16x2_t __attribute__((ext_vector_type(2)));
__device__ __forceinline__ unsigned cvtpk_s(float lo,float hi){f32x2_t v={lo,hi};bf16x2_t b=__builtin_convertvector(v,bf16x2_t);return __builtin_bit_cast(unsigned,b);}
#define WAIT_BAR(N) asm volatile("s_waitcnt vmcnt(" #N ") lgkmcnt(0)\n\ts_barrier":::"memory")

__device__ __forceinline__ void qkt(f32x16&p0,f32x16&p1,const char*Kslot,const bf16x8*qr,int r32,int hi){
  const char*kb=Kslot+hi*1024+r32*16;
  #pragma unroll
  for(int d0=0;d0<4;++d0){
    const bf16x8 b0=*reinterpret_cast<const bf16x8*>(kb+d0*2048);
    const bf16x8 b1=*reinterpret_cast<const bf16x8*>(kb+d0*2048+512);
    {p0=__builtin_amdgcn_mfma_f32_32x32x16_bf16(b0,qr[d0],p0,0,0,0);p1=__builtin_amdgcn_mfma_f32_32x32x16_bf16(b1,qr[d0],p1,0,0,0);}}
}
typedef __attribute__((address_space(3))) const char* lds_cptr;
typedef short v4i16_t __attribute__((ext_vector_type(4)));
__device__ __forceinline__ void kload8(bf16x8*kf,lds_cptr kp){
  kf[0]=*(const __attribute__((address_space(3))) bf16x8*)(kp);      kf[1]=*(const __attribute__((address_space(3))) bf16x8*)(kp+512);
  kf[2]=*(const __attribute__((address_space(3))) bf16x8*)(kp+2048); kf[3]=*(const __attribute__((address_space(3))) bf16x8*)(kp+2560);
  kf[4]=*(const __attribute__((address_space(3))) bf16x8*)(kp+4096); kf[5]=*(const __attribute__((address_space(3))) bf16x8*)(kp+4608);
  kf[6]=*(const __attribute__((address_space(3))) bf16x8*)(kp+6144); kf[7]=*(const __attribute__((address_space(3))) bf16x8*)(kp+6656);
}
__device__ __forceinline__ void kload2(bf16x8*kf,lds_cptr kp,int j){ kf[2*j]=*(const __attribute__((address_space(3))) bf16x8*)(kp+j*2048); kf[2*j+1]=*(const __attribute__((address_space(3))) bf16x8*)(kp+j*2048+512); }
__device__ __forceinline__ s16x4 vtr(lds_cptr p){ return __builtin_bit_cast(s16x4,__builtin_amdgcn_ds_read_tr16_b64_v4i16((__attribute__((address_space(3))) v4i16_t*)p)); }
__device__ __forceinline__ float rowmax(const f32x16&p0,const f32x16&p1){
  float a=max3f(p0[0],p0[1],p1[0]),b=max3f(p0[2],p0[3],p1[1]);a=max3f(a,p1[2],p1[3]);
  #pragma unroll
  for(int r=4;r<16;r+=4){a=max3f(a,p0[r],p0[r+1]);b=max3f(b,p0[r+2],p0[r+3]);a=max3f(a,p1[r],p1[r+1]);b=max3f(b,p1[r+2],p1[r+3]);}
  const float m=max2f(a,b);
  auto rr=__builtin_amdgcn_permlane32_swap(__float_as_uint(m),__float_as_uint(m),false,false);
  return max2f(__uint_as_float(rr[0]),__uint_as_float(rr[1]));
}
__device__ __forceinline__ void pv(f32x16*o,int vb,bf16x8 pa0,bf16x8 pa1,bf16x8 pa2,bf16x8 pa3){
  #pragma unroll
  for(int d0=0;d0<2;++d0){s16x4 lo[4],hi[4];
    #pragma unroll
    for(int ks=0;ks<4;++ks){
      asm volatile("ds_read_b64_tr_b16 %0,%1 offset:%c2":"=&v"(lo[ks]):"v"(vb),"i"(d0*4096+ks*1024):"memory");
      asm volatile("ds_read_b64_tr_b16 %0,%1 offset:%c2":"=&v"(hi[ks]):"v"(vb),"i"(d0*4096+ks*1024+512):"memory");}
    asm volatile("s_waitcnt lgkmcnt(0)":::"memory");SBAR();
    #define PK(k) (bf16x8){lo[k][0],lo[k][1],lo[k][2],lo[k][3],hi[k][0],hi[k][1],hi[k][2],hi[k][3]}
    o[d0]=__builtin_amdgcn_mfma_f32_32x32x16_bf16(pa0,PK(0),o[d0],0,0,0);
    o[d0]=__builtin_amdgcn_mfma_f32_32x32x16_bf16(pa1,PK(1),o[d0],0,0,0);
    o[d0]=__builtin_amdgcn_mfma_f32_32x32x16_bf16(pa2,PK(2),o[d0],0,0,0);
    o[d0]=__builtin_amdgcn_mfma_f32_32x32x16_bf16(pa3,PK(3),o[d0],0,0,0);
    #undef PK
  }
}

#ifndef ATTN_STORE16
#define ATTN_STORE16(p,v) (*(u32x4*)(p)=(v))
#endif
template<int THRL> __device__ __forceinline__ void attn_unit(int b,int h,int qb,const bf16*Q,const bf16*__restrict__ K,const bf16*__restrict__ V,bf16*O,char*shm,const float*fxf,float bfh){
  int tid_o=threadIdx.x; asm volatile("":"+v"(tid_o)); const int tid=tid_o,lane=tid&63,r32=lane&31,hi=lane>>5; const int wid=__builtin_amdgcn_readfirstlane(tid>>6);
  const long rowbase=(long)b*SEQ; const int q0=qb*QB;
  const lds_cptr shm3b=(lds_cptr)shm;

  {
    float* bl=(float*)(shm+LDS_BIAS); float* sc=(float*)(shm+LDS_SCAN);
    const int nkeys=q0+QB; const int s0=4*tid; float c0=0.f,c1=0.f,c2=0.f,c3=0.f;
    if(s0<nkeys){ const float* fp=fxf+((long)(rowbase+s0))*8+h; float z0=fp[0]+bfh,z1=fp[8]+bfh,z2=fp[16]+bfh,z3=fp[24]+bfh;
      c0=fminf(z0,0.f)-log1pf(expf(-fabsf(z0))); c1=c0+(fminf(z1,0.f)-log1pf(expf(-fabsf(z1)))); c2=c1+(fminf(z2,0.f)-log1pf(expf(-fabsf(z2)))); c3=c2+(fminf(z3,0.f)-log1pf(expf(-fabsf(z3)))); }
    float incl=c3;
    #pragma unroll
    for(int o=1;o<64;o<<=1){ const float t_=__shfl_up(incl,o); if(lane>=o)incl+=t_; }
    if(lane==63)sc[wid]=incl;
    __syncthreads();
    float woff=0.f;
    #pragma unroll
    for(int w_=0;w_<NW;++w_){ const float t_=sc[w_]; if(w_<wid)woff+=t_; }
    const float excl=woff+incl-c3; c0+=excl;c1+=excl;c2+=excl;c3+=excl;
    if(s0<nkeys){ bl[s0]=c0; bl[s0+1]=c1; bl[s0+2]=c2; bl[s0+3]=c3; }
    __syncthreads();
    const float cref=bl[q0];
    __syncthreads();
    const float L2E=1.4426950408889634f;
    if(s0<nkeys){ bl[s0]=(cref-c0)*L2E; bl[s0+1]=(cref-c1)*L2E; bl[s0+2]=(cref-c2)*L2E; bl[s0+3]=(cref-c3)*L2E; }
    __syncthreads();
  }
  const __attribute__((address_space(3))) float* bias3=(const __attribute__((address_space(3))) float*)(shm3b+LDS_BIAS)+4*hi;
  #define CINIT(P0,P1,t) do{ const __attribute__((address_space(3))) float* bp_=bias3+64*(t); \
    _Pragma("unroll") for(int g_=0;g_<4;++g_){ const f32x4b b0_=*(const __attribute__((address_space(3))) f32x4b*)(bp_+8*g_); const f32x4b b1_=*(const __attribute__((address_space(3))) f32x4b*)(bp_+32+8*g_); \
      P0[4*g_]=b0_[0]-mhat;P0[4*g_+1]=b0_[1]-mhat;P0[4*g_+2]=b0_[2]-mhat;P0[4*g_+3]=b0_[3]-mhat; P1[4*g_]=b1_[0]-mhat;P1[4*g_+1]=b1_[1]-mhat;P1[4*g_+2]=b1_[2]-mhat;P1[4*g_+3]=b1_[3]-mhat; } }while(0)
  const bf16*Qw=Q+(rowbase+q0+wid*QBLK)*DM+h*D;
  const bf16*Kh=K+rowbase*DM+h*D,*Vh=V+rowbase*DM+h*D;
  const unsigned lds0=(unsigned)(uintptr_t)shm;
  float*wsf=(float*)(shm+LDS_WS)+wid*64;
  const bf16*ksrc=Kh+(long)lane*DM+wid*8;
  const bf16*vsrc=Vh+(long)(16*(wid&3)+(lane>>2))*DM+(wid>>2)*32+(lane&3)*8;
  const unsigned kdst=lds0+LDS_K+wid*1024, vdst=lds0+LDS_V+wid*1024;
  #define DMA_K(t,slot) glds16(ksrc+(long)(t)*KVBLK*DM,(unsigned)__builtin_amdgcn_readfirstlane(kdst+(slot)))
  #define DMA_V(t,slot) glds16(vsrc+(long)(t)*KVBLK*DM,(unsigned)__builtin_amdgcn_readfirstlane(vdst+(slot)))
  const int vb0=(int)(lds0+LDS_V)+((lane>>4)&1)*32+(lane&3)*8+(4*hi+((lane&15)>>2))*64;
  const char*Kbase=shm+LDS_K; bf16x8 kf[8];
  const lds_cptr shm3=(lds_cptr)shm; const lds_cptr kp0=shm3+LDS_K+hi*1024+r32*16; const lds_cptr vp0=shm3+LDS_V+((lane>>4)&1)*32+(lane&3)*8+(4*hi+((lane&15)>>2))*64;
  const int NT=(q0+QB)/KVBLK;
  DMA_K(0,0);DMA_V(0,0);DMA_K(1,SLOTB);
  bf16x8 qr[4];
  #pragma unroll
  for(int d0=0;d0<4;++d0)qr[d0]=*reinterpret_cast<const bf16x8*>(&Qw[(long)r32*DM+d0*16+hi*8]);
  float mhat=0.f,l_reg=0.f;f32x16 o[2];o[0]=f32x16{};o[1]=f32x16{};
  const int qrel=wid*QBLK+r32;
  #define CMASK(P0,P1,t) do{int jb_=(t)-(NT-4); if(jb_>=0)cmask(P0,P1,jb_,qrel,hi);}while(0)
  bool resc=false;
  #define START(P0,P1) do{ const float rm=rowmax(P0,P1); resc=false; \
    { const float dl=rm; mhat=fadd_s(mhat,dl); \
      _Pragma("unroll") for(int r=0;r<16;++r){P0[r]=fsub_s(P0[r],dl);P1[r]=fsub_s(P1[r],dl);} \
      } \
    _Pragma("unroll") for(int r=0;r<16;++r)P0[r]=__builtin_amdgcn_exp2f(P0[r]); }while(0)
  #define RESC() do{ if(resc){ asm volatile("s_waitcnt lgkmcnt(0)":::"memory"); \
      _Pragma("unroll") for(int d_=0;d_<2;++d_) _Pragma("unroll") for(int r=0;r<16;++r)o[d_][r]*=wsf[crow(r,hi)]; } }while(0)
  f32x16 pA0,pA1,pB0,pB1;
  int sl_prev=0,sl_cur=0,sl_next=SLOTB;
  #define ROT() do{sl_prev=sl_cur;sl_cur=sl_next;sl_next=(sl_next==(NSLOT-1)*SLOTB)?0:sl_next+SLOTB;}while(0)
  DMA_K(2,2*SLOTB);
  WAIT_BAR(3);
  CINIT(pA0,pA1,0); qkt(pA0,pA1,Kbase,qr,r32,hi);asm volatile("s_nop 15\n\ts_nop 7":"+v"(pA0),"+v"(pA1));CMASK(pA0,pA1,0);
  START(pA0,pA1);
  _Pragma("unroll") for(int r=0;r<16;++r)pA1[r]=__builtin_amdgcn_exp2f(pA1[r]);
  WAIT_BAR(0);
  DMA_K(3,0);DMA_V(1,SLOTB);
  ROT();
  kload8(kf,kp0+sl_cur);
  WAIT_BAR(2);
  s16x4 vlo[8],vhi[8]; u32x4 pw0,pw1,pw2,pw3;
  #define PKW(P,B) cvtpk_s(P[B],P[B+1])
  #define PAF(k) __builtin_bit_cast(bf16x8,pw##k)
  #define VFR(i) (bf16x8){vlo[i][0],vlo[i][1],vlo[i][2],vlo[i][3],vhi[i][0],vhi[i][1],vhi[i][2],vhi[i][3]}
  #define PIN(x) asm volatile("":"+v"(x))
  #define MX3(a,b,c) __builtin_fmaxf(__builtin_fmaxf((a),(b)),(c))
  #define GAPA(MF,A0,A1,A2,A3,W0,W1,PW) do{ MF; sacc+=A0; sacc+=A1; sacc+=A2; sacc+=A3; PIN(sacc); W0; W1; PIN(PW); SBAR(); }while(0)
  #define EX(v) __builtin_amdgcn_exp2f(v)
  #define GAPB(MF,X,B) do{ MF; X[B]=EX(X[B]); X[B+1]=EX(X[B+1]); X[B+2]=EX(X[B+2]); X[B+3]=EX(X[B+3]); PIN(X); SBAR(); }while(0)
  #define VRD(i) do{ vlo[i]=vtr(vp_+(((i)>>2)*4096+((i)&3)*1024)); vhi[i]=vtr(vp_+(((i)>>2)*4096+((i)&3)*1024+512)); }while(0)
  #define KRD(G,j) do{ if(G){ kload2(kf,kp0+sl_next,j); SBAR(); } }while(0)
  #define STEP(C0,C1,P0,P1,t,GK,GV,GL) do{ SBAR(); CINIT(C0,C1,t); SBAR(); \
    const lds_cptr vp_=vp0+sl_prev; \
    VRD(0); SBAR(); float sacc=(P0[0]+P0[1]); \
    GAPA(C0=__builtin_amdgcn_mfma_f32_32x32x16_bf16(kf[0],qr[0],C0,0,0,0), P0[2],P0[3],P0[4],P0[5],     pw0[0]=PKW(P0,0), pw0[1]=PKW(P0,2), pw0); \
    VRD(4); SBAR(); GAPA(C1=__builtin_amdgcn_mfma_f32_32x32x16_bf16(kf[1],qr[0],C1,0,0,0), P0[6],P0[7],P0[8],P0[9],     pw0[2]=PKW(P0,4), pw0[3]=PKW(P0,6), pw0); \
    VRD(1); SBAR(); GAPA(C0=__builtin_amdgcn_mfma_f32_32x32x16_bf16(kf[2],qr[1],C0,0,0,0),   P0[10],P0[11],P0[12],P0[13], pw1[0]=PKW(P0,8), pw1[1]=PKW(P0,10), pw1); \
    VRD(5); SBAR(); GAPA(C1=__builtin_amdgcn_mfma_f32_32x32x16_bf16(kf[3],qr[1],C1,0,0,0),   P0[14],P0[15],P1[0],P1[1],   pw1[2]=PKW(P0,12),pw1[3]=PKW(P0,14), pw1); \
    VRD(2); SBAR(); GAPA(C0=__builtin_amdgcn_mfma_f32_32x32x16_bf16(kf[4],qr[2],C0,0,0,0),   P1[2],P1[3],P1[4],P1[5],     pw2[0]=PKW(P1,0), pw2[1]=PKW(P1,2), pw2); \
    VRD(6); SBAR(); GAPA(C1=__builtin_amdgcn_mfma_f32_32x32x16_bf16(kf[5],qr[2],C1,0,0,0),   P1[6],P1[7],P1[8],P1[9],     pw2[2]=PKW(P1,4), pw2[3]=PKW(P1,6), pw2); \
    VRD(3); SBAR(); GAPA(C0=__builtin_amdgcn_mfma_f32_32x32x16_bf16(kf[6],qr[3],C0,0,0,0),   P1[10],P1[11],P1[12],P1[13], pw3[0]=PKW(P1,8), pw3[1]=PKW(P1,10), pw3); \
    VRD(7); SBAR(); GAPA(C1=__builtin_amdgcn_mfma_f32_32x32x16_bf16(kf[7],qr[3],C1,0,0,0),   P1[14],P1[15],0.f,0.f,       pw3[2]=PKW(P1,12),pw3[3]=PKW(P1,14), pw3); \
    l_reg+=sacc; \
    if(GK){DMA_K((t)+3,sl_cur);} if(GV){DMA_V((t)+1,sl_next);} \
    CMASK(C0,C1,t); \
    { float a=MX3(C0[0],C0[1],C1[0]),b=MX3(C0[2],C0[3],C1[1]); a=MX3(a,C1[2],C1[3]); \
      _Pragma("unroll") for(int r=4;r<16;r+=4){a=MX3(a,C0[r],C0[r+1]);b=MX3(b,C0[r+2],C0[r+3]);a=MX3(a,C1[r],C1[r+1]);b=MX3(b,C1[r+2],C1[r+3]);} \
      float rm=__builtin_fmaxf(a,b); { auto rr=__builtin_amdgcn_permlane32_swap(__float_as_uint(rm),__float_as_uint(rm),false,false); rm=__builtin_fmaxf(__uint_as_float(rr[0]),__uint_as_float(rr[1])); } \
      resc=false; \
      if(__builtin_expect(__any(rm>(float)THRL),0)){ const float dl=__builtin_fmaxf(rm,0.f); mhat+=dl; \
        _Pragma("unroll") for(int r=0;r<16;++r){C0[r]-=dl;C1[r]-=dl;} \
        const float f=__builtin_amdgcn_exp2f(-dl); l_reg*=f; if(hi==0)wsf[r32]=f; resc=true; } } \
    SBAR(); \
    GAPB(o[0]=__builtin_amdgcn_mfma_f32_32x32x16_bf16(PAF(0),VFR(0),o[0],0,0,0), C0,0); \
    GAPB(o[1]=__builtin_amdgcn_mfma_f32_32x32x16_bf16(PAF(0),VFR(4),o[1],0,0,0), C0,4); \
    KRD(GL,0); GAPB(o[0]=__builtin_amdgcn_mfma_f32_32x32x16_bf16(PAF(1),VFR(1),o[0],0,0,0), C0,8); \
    KRD(GL,1); GAPB(o[1]=__builtin_amdgcn_mfma_f32_32x32x16_bf16(PAF(1),VFR(5),o[1],0,0,0), C0,12); \
    KRD(GL,2); GAPB(o[0]=__builtin_amdgcn_mfma_f32_32x32x16_bf16(PAF(2),VFR(2),o[0],0,0,0), C1,0); \
    KRD(GL,3); GAPB(o[1]=__builtin_amdgcn_mfma_f32_32x32x16_bf16(PAF(2),VFR(6),o[1],0,0,0), C1,4); \
    GAPB(o[0]=__builtin_amdgcn_mfma_f32_32x32x16_bf16(PAF(3),VFR(3),o[0],0,0,0), C1,8); \
    GAPB(o[1]=__builtin_amdgcn_mfma_f32_32x32x16_bf16(PAF(3),VFR(7),o[1],0,0,0), C1,12); \
    }while(0)
  int t=1;
  #undef CMASK
  #define CMASK(P0,P1,t) do{}while(0)
  for(;t+5<NT;t+=2){
    STEP(pB0,pB1,pA0,pA1,t,true,true,true);     WAIT_BAR(2); RESC(); ROT();
    STEP(pA0,pA1,pB0,pB1,t+1,true,true,true);   WAIT_BAR(2); RESC(); ROT();
  }
  #undef CMASK
  #define CMASK(P0,P1,t) do{int jb_=(t)-(NT-4); if(jb_>=0)cmask(P0,P1,jb_,qrel,hi);}while(0)
  #define ENDW(tt) do{ if((tt)+3<NT){WAIT_BAR(2);} else if((tt)+2<NT){WAIT_BAR(1);} else {WAIT_BAR(0);} }while(0)
  for(;t+1<NT;t+=2){
    STEP(pB0,pB1,pA0,pA1,t,(t+3<NT),(t+1<NT),(t+1<NT));       ENDW(t);   RESC(); ROT();
    STEP(pA0,pA1,pB0,pB1,t+1,(t+4<NT),(t+2<NT),(t+2<NT));     ENDW(t+1); RESC(); ROT();
  }
  STEP(pB0,pB1,pA0,pA1,NT-1,false,false,false); RESC();
  { float sacc=pB0[0]+pB0[1]; _Pragma("unroll") for(int r=2;r<16;++r)sacc+=pB0[r]; _Pragma("unroll") for(int r=0;r<16;++r)sacc+=pB1[r]; l_reg+=sacc;
    pw0=(u32x4){PKW(pB0,0),PKW(pB0,2),PKW(pB0,4),PKW(pB0,6)};pw1=(u32x4){PKW(pB0,8),PKW(pB0,10),PKW(pB0,12),PKW(pB0,14)};pw2=(u32x4){PKW(pB1,0),PKW(pB1,2),PKW(pB1,4),PKW(pB1,6)};pw3=(u32x4){PKW(pB1,8),PKW(pB1,10),PKW(pB1,12),PKW(pB1,14)};
    SBAR(); pv(o,vb0+sl_cur,PAF(0),PAF(1),PAF(2),PAF(3)); }
  #undef PKW
  #undef PAF
  #undef VFR
  #undef PIN
  #undef MX3
  #undef GAPA
  #undef GAPB
  #undef EX
  #undef VRD
  #undef KRD
  #undef STEP
  #undef ENDW
  {auto rr=__builtin_amdgcn_permlane32_swap(__float_as_uint(l_reg),__float_as_uint(l_reg),false,false);l_reg=__uint_as_float(rr[0])+__uint_as_float(rr[1]);}
  if(hi==0)wsf[32+r32]=l_reg;asm volatile("s_waitcnt lgkmcnt(0)":::"memory");
  float rli[16];
  #pragma unroll
  for(int r=0;r<16;++r)rli[r]=__builtin_amdgcn_rcpf(wsf[32+crow(r,hi)]);
  bf16*Ow=O+(rowbase+q0+wid*QBLK)*DM+h*D;
  { bf16*stg=(bf16*)(shm+LDS_OST)+wid*2048;
    #pragma unroll
    for(int r=0;r<16;++r){const int orow=crow(r,hi);
      #pragma unroll
      for(int d0=0;d0<2;++d0)stg[orow*64+d0*32+r32]=__float2bfloat16(o[d0][r]*rli[r]);}
    asm volatile("s_waitcnt lgkmcnt(0)":::"memory");
    #pragma unroll
    for(int i=0;i<4;++i){const int row=i*8+(lane>>3),ch=lane&7; const u32x4 v=*(const u32x4*)(stg+row*64+ch*8); ATTN_STORE16(Ow+(long)row*DM+ch*8,v);} }
  asm volatile("s_waitcnt lgkmcnt(0)\n\ts_barrier":::"memory");
  #undef CINIT
  #undef DMA_K
  #undef DMA_V
  #undef CMASK
  #undef START
  #undef RESC
  #undef ROT
}
constexpr int ATTN_LDS_BYTES=LDS_BYTES;
struct AttnTensors { const bf16* Q; const bf16* K; const bf16* V; bf16* O; const float* fxf; const float* bf; };
struct AttnUnit { int bh; int qb; };
struct StaticOrder {
  int vcu;
  __device__ __forceinline__ explicit StaticOrder(int grid,int block):vcu((grid%8==0)?((block%8)*(grid/8)+block/8):block){}
  __device__ __forceinline__ bool next(int i,AttnUnit&u)const{ const int idx=vcu+ (i>>1)*0; if(i>=2||idx>=256)return false; const int s=idx&3; u.bh=idx>>2; u.qb=(i==0)?s:7-s; return true; }
  __device__ __forceinline__ void a_ready(const AttnUnit&)const{}
  __device__ __forceinline__ void done(const AttnUnit&)const{}
};
template<class Sched,int THRL=8> __device__ __forceinline__ void attn_phase(char*lds,const AttnTensors&T,const Sched&S){
  AttnUnit u;
  for(int i=0;S.next(i,u);++i){ S.a_ready(u); attn_unit<THRL>(u.bh/NHEAD,u.bh%NHEAD,u.qb,T.Q,T.K,T.V,T.O,lds,T.fxf,T.bf[u.bh%NHEAD]); S.done(u); }
}
#undef SBAR
#undef WAIT_BAR
}

constexpr int M = 16384, DMOD = 1024, SEQL = 2048, FFN_H = 2816, INTOT = 7176;
constexpr size_t MiB = 1u << 20;
constexpr size_t WS_HB = 0, WS_HBL = 32 * MiB, WS_YA = 64 * MiB, WS_YB = 80 * MiB, WS_YC = 96 * MiB;
constexpr size_t WS_FK = WS_YA, WS_FQ = WS_YB, WS_FV = WS_YC;
constexpr size_t WS_ZQ = 112 * MiB, WS_ZF = 128 * MiB, WS_ZI = 160 * MiB, WS_ZG = 176 * MiB, WS_SU = 192 * MiB, WS_KV = 208 * MiB, WS_SE = 240 * MiB, WS_MISC = 248 * MiB;
constexpr size_t WS_GATES = 112 * MiB, WS_MERGED = 208 * MiB, WS_PRE = 112 * MiB, WS_H1B = 176 * MiB, WS_FFH = 0;
constexpr size_t MISC_FXF = 0, MISC_DEC = 1 * MiB, MISC_LB = 2 * MiB;
constexpr size_t DO_WIN = 0, DO_WGLU = 14 * MiB, DO_WBR = 14 * MiB + MiB / 2, DO_WOUT = 17 * MiB + MiB / 2, DO_WGU = 19 * MiB + MiB / 2, DO_WDN = 30 * MiB + MiB / 2,
                 DO_TM = 36 * MiB, DO_EM = 42 * MiB, DO_LAM = 44 * MiB, DO_YG = 48 * MiB;
constexpr int LDS_BYTES = 147456;
constexpr float DN_ALPHA = 1.4142135623730951f, LN_EPS = 1e-5f, RMS_EPS = 1e-6f;

typedef unsigned short u16;
typedef unsigned v4u __attribute__((ext_vector_type(4)));
typedef unsigned v2u __attribute__((ext_vector_type(2)));
typedef float f32x4 __attribute__((ext_vector_type(4)));
typedef short bf16x8 __attribute__((ext_vector_type(8)));
__device__ __forceinline__ unsigned f2bf(float f) { unsigned u = __builtin_bit_cast(unsigned, f); return (u + 0x7fffu + ((u >> 16) & 1u)) >> 16; }
__device__ __forceinline__ unsigned pk2(float lo, float hi) { return f2bf(lo) | (f2bf(hi) << 16); }
__device__ __forceinline__ float bf2f(unsigned h) { return __builtin_bit_cast(float, h << 16); }
__device__ __forceinline__ float bflo(unsigned w) { return __builtin_bit_cast(float, w << 16); }
__device__ __forceinline__ float bfhi(unsigned w) { return __builtin_bit_cast(float, w & 0xffff0000u); }
__device__ __forceinline__ float sigm(float x) { return 1.f / (1.f + __expf(-x)); }
__device__ __forceinline__ float wave_sum(float v) {
#pragma unroll
    for (int o = 1; o < 64; o <<= 1) v += __shfl_xor(v, o);
    return v;
}

struct Args { const float* in[25]; float* out; unsigned char* ws; };

namespace pg8 {
struct EpiIn {
    static constexpr bool PERM = true, AFTER_DRAIN = false, KEEP_ACC = false;
    unsigned char* ws; const float* lb; float c2;
    __device__ __forceinline__ void operator()(f32x4 (&acc)[2][2][4][2], const Unit& u, int wr, int wc, int fr, int fq) const {
        const int seg = u.pn >> 1;
        const int cbase = (u.pn & 1) * 256 + wc * 32 + 8 * fq;
        const int row0 = (u.pm * BM) + wr * 64 + fr;
#pragma unroll
        for (int ai = 0; ai < 2; ++ai)
#pragma unroll
            for (int m = 0; m < 4; ++m) {
                const int row = row0 + ai * HALF + m * 16;
#pragma unroll
                for (int bj = 0; bj < 2; ++bj) {
                    const int c = cbase + bj * HALF;
                    f32x4 v0 = acc[ai][bj][m][0], v1 = acc[ai][bj][m][1];
                    if (seg == 1) {
                        const f32x4 l0 = *(const f32x4*)(lb + c), l1 = *(const f32x4*)(lb + c + 4);
#pragma unroll
                        for (int e = 0; e < 4; ++e) { v0[e] = __logf(l0[e] + (1.f - l0[e]) * sigm(v0[e])); v1[e] = __logf(l1[e] + (1.f - l1[e]) * sigm(v1[e])); }
                        float* p = (float*)(ws + WS_ZF) + (size_t)row * 512 + c;
                        *(f32x4*)p = v0; *(f32x4*)(p + 4) = v1;
                    } else {
                        if (seg == 4) { v0 = v0 * c2; v1 = v1 * c2; }
                        u32x4 w; w.x = cvt_pk_bf16(v0[0], v0[1]); w.y = cvt_pk_bf16(v0[2], v0[3]); w.z = cvt_pk_bf16(v1[0], v1[1]); w.w = cvt_pk_bf16(v1[2], v1[3]);
                        size_t off;
                        if (seg == 7) off = WS_SU + 2 * (((size_t)((c >> 4) * 1024 + (row >> 4))) * 256 + (size_t)((row & 15) * 16 + (c & 15)));
                        else {
                            const size_t base = seg == 0 ? WS_ZQ : seg == 2 ? WS_ZI : seg == 3 ? WS_ZG : seg == 4 ? WS_FQ : seg == 5 ? WS_FK : WS_FV;
                            off = base + 2 * ((size_t)row * 512 + c);
                        }
                        *(u32x4*)(ws + off) = w;
                    }
                }
            }
    }
};
struct EpiGate {
    static constexpr bool PERM = true, AFTER_DRAIN = false, KEEP_ACC = false;
    bf16_t* G;
    __device__ __forceinline__ void operator()(f32x4 (&acc)[2][2][4][2], const Unit& u, int wr, int wc, int fr, int fq) const {
        const int col0 = u.pn * BM + wc * 32 + 8 * fq, row0 = u.pm * BM + wr * 64 + fr;
#pragma unroll
        for (int ai = 0; ai < 2; ++ai)
#pragma unroll
            for (int m = 0; m < 4; ++m) { bf16_t* rowp = G + (size_t)(row0 + ai * HALF + m * 16) * 3072 + col0;
#pragma unroll
                for (int bj = 0; bj < 2; ++bj) { const f32x4 v0 = acc[ai][bj][m][0], v1 = acc[ai][bj][m][1];
                    u32x4 w; w.x = cvt_pk_bf16(sigm(v0[0]), sigm(v0[1])); w.y = cvt_pk_bf16(sigm(v0[2]), sigm(v0[3])); w.z = cvt_pk_bf16(sigm(v1[0]), sigm(v1[1])); w.w = cvt_pk_bf16(sigm(v1[2]), sigm(v1[3]));
                    *(u32x4*)(rowp + bj * HALF) = w; } }
    }
};
struct EpiGlu {
    static constexpr bool PERM = true, AFTER_DRAIN = false, KEEP_ACC = false;
    const bf16_t* Y; bf16_t* O;
    __device__ __forceinline__ void operator()(f32x4 (&acc)[2][2][4][2], const Unit& u, int wr, int wc, int fr, int fq) const {
        const int col0 = u.pn * BM + wc * 32 + 8 * fq, row0 = u.pm * BM + wr * 64 + fr;
#pragma unroll
        for (int ai = 0; ai < 2; ++ai)
#pragma unroll
            for (int m = 0; m < 4; ++m) { const size_t ro = (size_t)(row0 + ai * HALF + m * 16) * 512 + col0;
#pragma unroll
                for (int bj = 0; bj < 2; ++bj) { const f32x4 v0 = acc[ai][bj][m][0], v1 = acc[ai][bj][m][1];
                    const u32x4 y = *(const u32x4*)(Y + ro + bj * HALF);
                    u32x4 w; w.x = cvt_pk_bf16(bflo(y.x) * sigm(v0[0]), bfhi(y.x) * sigm(v0[1])); w.y = cvt_pk_bf16(bflo(y.y) * sigm(v0[2]), bfhi(y.y) * sigm(v0[3]));
                    w.z = cvt_pk_bf16(bflo(y.z) * sigm(v1[0]), bfhi(y.z) * sigm(v1[1])); w.w = cvt_pk_bf16(bflo(y.w) * sigm(v1[2]), bfhi(y.w) * sigm(v1[3]));
                    *(u32x4*)(O + ro + bj * HALF) = w; } }
    }
};
struct EpiBranch {
    static constexpr bool PERM = true, AFTER_DRAIN = false, KEEP_ACC = true;
    const bf16_t* G; bf16_t* O;
    __device__ __forceinline__ void operator()(f32x4 (&acc)[2][2][4][2], const Unit& u, int wr, int wc, int fr, int fq) const {
        const int br = u.pm >> 6, tm = u.pm & 63, tn = u.pn & 3;
        const int col0 = tn * BM + wc * 32 + 8 * fq, row0 = tm * BM + wr * 64 + fr;
#pragma unroll
        for (int ai = 0; ai < 2; ++ai)
#pragma unroll
            for (int m = 0; m < 4; ++m) { const size_t row = (size_t)(row0 + ai * HALF + m * 16);
#pragma unroll
                for (int bj = 0; bj < 2; ++bj) { f32x4 v0 = acc[ai][bj][m][0], v1 = acc[ai][bj][m][1];
                    const bf16_t* gp = G + row * 3072 + col0 + bj * HALF;
                    if (br < 2) {
                        const u32x4 ga = *(const u32x4*)(gp + br * 1024), gb = *(const u32x4*)(gp + (br + 1) * 1024);
                        v0[0] *= bflo(ga.x) * __builtin_amdgcn_rcpf(bflo(gb.x)); v0[1] *= bfhi(ga.x) * __builtin_amdgcn_rcpf(bfhi(gb.x));
                        v0[2] *= bflo(ga.y) * __builtin_amdgcn_rcpf(bflo(gb.y)); v0[3] *= bfhi(ga.y) * __builtin_amdgcn_rcpf(bfhi(gb.y));
                        v1[0] *= bflo(ga.z) * __builtin_amdgcn_rcpf(bflo(gb.z)); v1[1] *= bfhi(ga.z) * __builtin_amdgcn_rcpf(bfhi(gb.z));
                        v1[2] *= bflo(ga.w) * __builtin_amdgcn_rcpf(bflo(gb.w)); v1[3] *= bfhi(ga.w) * __builtin_amdgcn_rcpf(bfhi(gb.w));
                        acc[ai][bj][m][0] = v0; acc[ai][bj][m][1] = v1;
                    } else {
                        const u32x4 ga = *(const u32x4*)(gp + 2048);
                        u32x4 w; w.x = cvt_pk_bf16(v0[0] * bflo(ga.x), v0[1] * bfhi(ga.x)); w.y = cvt_pk_bf16(v0[2] * bflo(ga.y), v0[3] * bfhi(ga.y));
                        w.z = cvt_pk_bf16(v1[0] * bflo(ga.z), v1[1] * bfhi(ga.z)); w.w = cvt_pk_bf16(v1[2] * bflo(ga.w), v1[3] * bfhi(ga.w));
                        *(u32x4*)(O + row * 1024 + col0 + bj * HALF) = w;
                        acc[ai][bj][m][0] = (f32x4){0.f, 0.f, 0.f, 0.f}; acc[ai][bj][m][1] = (f32x4){0.f, 0.f, 0.f, 0.f};
                    } } }
    }
};
struct BranchOrder {
    StaticOrder so;
    __host__ __device__ void init(int G_, int c_) { so.init(16384, 1024, G_, c_); }
    __host__ __device__ bool next(int i, Unit& u) const { const int r = i / 3, br = i - 3 * r; Unit t; if (!so.next(r, t)) return false; u.pm = t.pm + 64 * br; u.pn = t.pn + 4 * br; return true; }
    __device__ __forceinline__ void a_ready(const Unit&) const {}
    __device__ __forceinline__ void done(const Unit&) const {}
};
struct EpiRes {
    static constexpr bool PERM = false, AFTER_DRAIN = false, KEEP_ACC = false;
    const float* resf; const bf16_t* rhi; const bf16_t* rlo; float* out;
    __device__ __forceinline__ void operator()(f32x4 (&acc)[2][2][4][2], const Unit& u, int wr, int wc, int fr, int fq) const {
        const int col0 = u.pn * BM + wc * 32 + 4 * fq, row0 = u.pm * BM + wr * 64 + fr;
#pragma unroll
        for (int ai = 0; ai < 2; ++ai)
#pragma unroll
            for (int m = 0; m < 4; ++m) { const size_t ro = (size_t)(row0 + ai * HALF + m * 16) * 1024 + col0;
#pragma unroll
                for (int bj = 0; bj < 2; ++bj)
#pragma unroll
                    for (int n = 0; n < 2; ++n) { const size_t o = ro + bj * HALF + n * 16; f32x4 r;
                        if (resf) r = *(const f32x4*)(resf + o);
                        else { const v2u h = *(const v2u*)(rhi + o), l = *(const v2u*)(rlo + o); r[0] = bflo(h.x) + bflo(l.x); r[1] = bfhi(h.x) + bfhi(l.x); r[2] = bflo(h.y) + bflo(l.y); r[3] = bfhi(h.y) + bfhi(l.y); }
                        *(f32x4*)(out + o) = r * 1.4142135623730951f + acc[ai][bj][m][n]; } }
    }
};
struct EpiSwiglu {
    static constexpr bool PERM = true, AFTER_DRAIN = false, KEEP_ACC = false;
    bf16_t* O;
    __device__ __forceinline__ void operator()(f32x4 (&acc)[2][2][4][2], const Unit& u, int wr, int wc, int fr, int fq) const {
        const int col0 = u.pn * 128 + wc * 32 + 8 * fq, row0 = u.pm * BM + wr * 64 + fr;
#pragma unroll
        for (int ai = 0; ai < 2; ++ai)
#pragma unroll
            for (int m = 0; m < 4; ++m) { const f32x4 g0 = acc[ai][0][m][0], g1 = acc[ai][0][m][1], u0 = acc[ai][1][m][0], u1 = acc[ai][1][m][1];
                u32x4 w; w.x = cvt_pk_bf16(g0[0] * sigm(g0[0]) * u0[0], g0[1] * sigm(g0[1]) * u0[1]); w.y = cvt_pk_bf16(g0[2] * sigm(g0[2]) * u0[2], g0[3] * sigm(g0[3]) * u0[3]);
                w.z = cvt_pk_bf16(g1[0] * sigm(g1[0]) * u1[0], g1[1] * sigm(g1[1]) * u1[1]); w.w = cvt_pk_bf16(g1[2] * sigm(g1[2]) * u1[2], g1[3] * sigm(g1[3]) * u1[3]);
                *(u32x4*)(O + (size_t)(row0 + ai * HALF + m * 16) * 2816 + col0) = w; }
    }
};
}
#define GAS __attribute__((address_space(1)))
#define LAS __attribute__((address_space(3)))
typedef unsigned short bf16;
typedef unsigned v4u __attribute__((ext_vector_type(4)));
typedef float f32x4 __attribute__((ext_vector_type(4)));
typedef short bf16x8 __attribute__((ext_vector_type(8)));
typedef GAS unsigned gu32;
typedef GAS unsigned long long gu64;
#define RLX_AGENT __ATOMIC_RELAXED, __HIP_MEMORY_SCOPE_AGENT
#define LDS_WAIT() asm volatile("s_waitcnt lgkmcnt(0)" ::: "memory")
#define VM_WAIT() asm volatile("s_waitcnt vmcnt(0)" ::: "memory")
__device__ __forceinline__ unsigned long long rt() { return __builtin_amdgcn_s_memrealtime(); }
#define XB_TMO      128
#define XB_XCNT(j)  (256  + 64 * (j))
#define XB_XSUB(j)  (1280 + 64 * (j))
#define XB_XGEN(j)  (2304 + 64 * (j))
#define XB_TOP      3328
#define XB_TOPGEN   3392
#define XCD_BAR_WORDS 3456
#define XB_SPIN_CAP (1u << 18)

__device__ __forceinline__ unsigned xb_ld(unsigned* p)              { return __hip_atomic_load(p, __ATOMIC_RELAXED, __HIP_MEMORY_SCOPE_AGENT); }
__device__ __forceinline__ unsigned xb_add(unsigned* p, unsigned v) { return __hip_atomic_fetch_add(p, v, __ATOMIC_RELAXED, __HIP_MEMORY_SCOPE_AGENT); }
__device__ __forceinline__ unsigned xb_xcc_id() { return (unsigned)__builtin_amdgcn_s_getreg((3 << 11) | 20) & 0xFu; }
#define XB_SPIN(cond, bar) do { unsigned _sp = 0; while (cond) { __builtin_amdgcn_s_sleep(1); \
    if ((++_sp & 255u) == 0u) { if (xb_ld(&(bar)[XB_TMO])) break; if (_sp > XB_SPIN_CAP) { atomicAdd(&(bar)[XB_TMO], 1u); break; } } } } while (0)

struct XcdBarrier {
    unsigned* bar; unsigned x;
    volatile LAS unsigned* st;
};

__device__ __forceinline__ XcdBarrier xcd_barrier_post(unsigned* bar, volatile LAS unsigned* st) {
    XcdBarrier b; b.bar = bar; b.x = xb_xcc_id(); b.st = st;
    if (threadIdx.x == 0) (void)xb_add(&bar[XB_XCNT(b.x)], 1u);
    return b;
}
__device__ __forceinline__ void xcd_barrier_complete(unsigned* bar, unsigned x, unsigned& nloc, unsigned& nx) {
    const unsigned G = gridDim.x * gridDim.y * gridDim.z;
    unsigned sum, cnt, mine, sp = 0u;
    for (;;) {
        sum = 0u; cnt = 0u; mine = 0u;
#pragma unroll
        for (unsigned j = 0; j < 16; ++j) { const unsigned c = xb_ld(&bar[XB_XCNT(j)]); sum += c; cnt += (c > 0u) ? 1u : 0u; mine = (j == x) ? c : mine; }
        if (sum == G) break;
        __builtin_amdgcn_s_sleep(1);
        if ((++sp & 255u) == 0u) { if (xb_ld(&bar[XB_TMO])) break; if (sp > XB_SPIN_CAP) { atomicAdd(&bar[XB_TMO], 1u); break; } }
    }
    nloc = mine > 0u ? mine : 1u; nx = cnt > 0u ? cnt : 1u;
}

__device__ __forceinline__ void xcd_barrier(const XcdBarrier& b) {
    asm volatile("s_waitcnt vmcnt(0)" ::: "memory");
    __syncthreads();
    if (threadIdx.x == 0) {
        unsigned* bar = b.bar;
        __builtin_amdgcn_s_waitcnt(0);
        unsigned nloc = b.st[0], nx = b.st[1];
        if (nloc == 0u) { xcd_barrier_complete(bar, b.x, nloc, nx); b.st[0] = nloc; b.st[1] = nx; }
        const unsigned old = xb_add(&bar[XB_XSUB(b.x)], 1u);
        const unsigned gen = old / nloc;
        if (old + 1u == (gen + 1u) * nloc) {
            __builtin_amdgcn_fence(__ATOMIC_RELEASE, "agent");
            asm volatile("s_waitcnt vmcnt(0)" ::: "memory");
            const unsigned og = xb_add(&bar[XB_TOP], 1u);
            const unsigned tg = og / nx;
            if (og + 1u == (tg + 1u) * nx) xb_add(&bar[XB_TOPGEN], 1u);
            else XB_SPIN(xb_ld(&bar[XB_TOPGEN]) == tg, bar);
            __builtin_amdgcn_fence(__ATOMIC_ACQUIRE, "agent");
            xb_add(&bar[XB_XGEN(b.x)], 1u);
            asm volatile("s_waitcnt vmcnt(0)" ::: "memory");
        } else {
            XB_SPIN(xb_ld(&bar[XB_XGEN(b.x)]) == gen, bar);
            __builtin_amdgcn_fence(__ATOMIC_ACQUIRE, "agent");
            asm volatile("s_waitcnt vmcnt(0)" ::: "memory");
        }
    }
    __syncthreads();
}

struct Frame { unsigned char* lds; unsigned char* ws; unsigned char* dout; int G, vcu; };
__device__ __forceinline__ int opq_tid() { int t = threadIdx.x; asm volatile("" : "+v"(t)); return t; }
#define F_TID (opq_tid())
#define F_LANE (opq_tid() & 63)
#define F_WAVE (__builtin_amdgcn_readfirstlane(opq_tid() >> 6))

__device__ __forceinline__ void cvt_item(const float* src, int ld, int K, int ncb, u16* dst, int grp, int stride, int base, int item, float* scr, int lane) {
    const int kb = item / ncb, nb = item - kb * ncb, k0 = 64 * kb, n0 = 32 * nb;
#pragma unroll 8
    for (int i = 0; i < 32; ++i) { const int kk = 2 * i + (lane >> 5); scr[kk * 33 + (lane & 31)] = src[(size_t)(k0 + kk) * ld + n0 + (lane & 31)]; }
    asm volatile("s_waitcnt lgkmcnt(0)" ::: "memory");
    const int c = lane & 7;
    const int drow0 = base + (n0 / grp) * stride + (n0 % grp);
#pragma unroll
    for (int j = 0; j < 4; ++j) { const int n = (lane >> 3) + 8 * j; const float* s = scr + (8 * c) * 33 + n;
        v4u o; o.x = pk2(s[0 * 33], s[1 * 33]); o.y = pk2(s[2 * 33], s[3 * 33]); o.z = pk2(s[4 * 33], s[5 * 33]); o.w = pk2(s[6 * 33], s[7 * 33]);
        *(v4u*)(dst + (size_t)(drow0 + n) * K + k0 + 8 * c) = o; }
    asm volatile("s_waitcnt lgkmcnt(0)" ::: "memory");
}
__device__ __forceinline__ void convert_weights(const Frame& F, const Args& a, int l) {
    float* scr = (float*)(F.lds + F_WAVE * 16384);
    const int gw = F.vcu * 8 + F_WAVE, NGW = F.G * 8;
    const float* win = a.in[1] + (size_t)l * DMOD * INTOT;
    unsigned char* d = F.dout;
    constexpr int BIG = 1 << 30;
    constexpr int I0 = 16 * 112, I1 = 16 * 16, I2 = 16 * 96, I3 = 8 * 16, I4 = 8 * 32, I7 = 16 * 32, I8 = 16 * 88, I10 = 44 * 32;
    constexpr int NIT = I0 + I1 + I2 + I3 + 3 * I4 + I7 + 2 * I8 + I10;
    for (int it = gw; it < NIT; it += NGW) {
        int r = it;
        if (r < I0) { cvt_item(win, INTOT, 1024, 112, (u16*)(d + DO_WIN), BIG, 0, 0, r, scr, F_LANE); continue; } r -= I0;
        if (r < I1) { cvt_item(win + 3592, INTOT, 1024, 16, (u16*)(d + DO_WIN), BIG, 0, 3584, r, scr, F_LANE); continue; } r -= I1;
        if (r < I2) { cvt_item(win + 4104, INTOT, 1024, 96, (u16*)(d + DO_WIN), BIG, 0, 4096, r, scr, F_LANE); continue; } r -= I2;
        if (r < I3) { cvt_item(a.in[13] + (size_t)l * 512 * 512, 512, 512, 16, (u16*)(d + DO_WGLU), BIG, 0, 0, r, scr, F_LANE); continue; } r -= I3;
        if (r < I4) { cvt_item(a.in[14] + (size_t)l * 512 * 1024, 1024, 512, 32, (u16*)(d + DO_WBR), BIG, 0, 0, r, scr, F_LANE); continue; } r -= I4;
        if (r < I4) { cvt_item(a.in[15] + (size_t)l * 512 * 1024, 1024, 512, 32, (u16*)(d + DO_WBR), BIG, 0, 1024, r, scr, F_LANE); continue; } r -= I4;
        if (r < I4) { cvt_item(a.in[16] + (size_t)l * 512 * 1024, 1024, 512, 32, (u16*)(d + DO_WBR), BIG, 0, 2048, r, scr, F_LANE); continue; } r -= I4;
        if (r < I7) { cvt_item(a.in[17] + (size_t)l * 1024 * 1024, 1024, 1024, 32, (u16*)(d + DO_WOUT), BIG, 0, 0, r, scr, F_LANE); continue; } r -= I7;
        if (r < I8) { cvt_item(a.in[20] + (size_t)l * 1024 * FFN_H, FFN_H, 1024, 88, (u16*)(d + DO_WGU), 128, 256, 0, r, scr, F_LANE); continue; } r -= I8;
        if (r < I8) { cvt_item(a.in[21] + (size_t)l * 1024 * FFN_H, FFN_H, 1024, 88, (u16*)(d + DO_WGU), 128, 256, 128, r, scr, F_LANE); continue; } r -= I8;
        cvt_item(a.in[22] + (size_t)l * FFN_H * 1024, 1024, FFN_H, 32, (u16*)(d + DO_WDN), BIG, 0, 0, r, scr, F_LANE);
    }
}

__device__ __forceinline__ void s5_mats(const Frame& F, const Args& a, int l) {
    float2* LP = (float2*)(F.lds);
    float2* BB = (float2*)(F.lds + 16384);
    float2* CC = (float2*)(F.lds + 32768);
    float* KT = (float*)(F.lds + 49152);
    u16* TM = (u16*)(F.dout + DO_TM); u16* EM = (u16*)(F.dout + DO_EM); float2* LAM = (float2*)(F.dout + DO_LAM);
    const int tid = F_TID;
    for (int unit = blockIdx.x; unit < 256; unit += F.G) {
        const int g = unit >> 3, part = unit & 7;
        __syncthreads();
        const float dt = __expf(a.in[7][l * 32 + g]);
        const float* lre = a.in[5] + (size_t)(l * 32 + g) * 64; const float* lim = a.in[6] + (size_t)(l * 32 + g) * 64;
        for (int e = tid; e < 17 * 64; e += 512) { const int tau = e >> 6, p = e & 63; const float mg = expf(lre[p] * dt * (float)tau); float sn, cs; sincosf(lim[p] * dt * (float)tau, &sn, &cs); LP[e] = make_float2(mg * cs, mg * sn); }
        for (int e = tid; e < 1024; e += 512) { const int p = e >> 4;
            const float lr = lre[p], li = lim[p]; const float mg = expf(lr * dt); float sn, cs; sincosf(li * dt, &sn, &cs);
            const float nr = mg * cs - 1.f, ni = mg * sn, den = 1.f / (lr * lr + li * li);
            const float qr = (nr * lr + ni * li) * den, qi = (ni * lr - nr * li) * den;
            const size_t bi = ((size_t)(l * 32 + g) * 64 + p) * 16 + (e & 15);
            const float br = a.in[8][bi], bim = a.in[9][bi];
            BB[e] = make_float2(qr * br - qi * bim, qr * bim + qi * br);
            const size_t ci = (size_t)(l * 32 + g) * 1024 + e;
            CC[e] = make_float2(a.in[10][ci], a.in[11][ci]); }
        __syncthreads();
        for (int e = tid; e < 4096; e += 512) { const int tau = e >> 8, hp = (e >> 4) & 15, h = e & 15; float s = 0.f;
            for (int p = 0; p < 64; ++p) { const float2 c = CC[hp * 64 + p], w = LP[tau * 64 + p], b = BB[p * 16 + h];
                const float wr_ = c.x * w.x - c.y * w.y, wi_ = c.x * w.y + c.y * w.x; s += wr_ * b.x - wi_ * b.y; }
            if (tau == 0 && hp == h) s += a.in[12][(size_t)(l * 32 + g) * 16 + h];
            KT[e] = s; }
        __syncthreads();
        for (int e = tid; e < 32 * 384; e += 512) { const int rr = e / 384, col = e - rr * 384; const int i = 2 * part + (rr >> 4), hp = rr & 15; float v;
            if (col < 256) { const int j = col >> 4, h = col & 15; v = (j <= i) ? KT[((i - j) * 16 + hp) * 16 + h] : 0.f; }
            else { const int p = (col - 256) & 63; const float2 c = CC[hp * 64 + p], w = LP[(i + 1) * 64 + p]; v = (col < 320) ? (c.x * w.x - c.y * w.y) : -(c.x * w.y + c.y * w.x); }
            TM[((size_t)g * 256 + i * 16 + hp) * 384 + col] = (u16)f2bf(v); }
        for (int e = tid; e < 16 * 256; e += 512) { const int r = 16 * part + (e >> 8), col = e & 255, j = col >> 4, h = col & 15, p = r & 63;
            const float2 w = LP[(15 - j) * 64 + p], b = BB[p * 16 + h];
            const float v = (r < 64) ? (w.x * b.x - w.y * b.y) : (w.x * b.y + w.y * b.x);
            EM[((size_t)g * 128 + r) * 256 + col] = (u16)f2bf(v); }
        if (part == 0 && tid < 64) LAM[g * 64 + tid] = LP[16 * 64 + tid];
    }
    __syncthreads();
}

template <int MODE> __device__ __forceinline__ void row_pass(const Frame& F, const Args& a, int l) {
    float* wfx = (float*)(F.lds + 131072 - 32768);
    const float* g = nullptr; const float* bb = nullptr;
    if (MODE == 1) { g = a.in[18] + l * 1024; bb = a.in[19] + l * 1024; }
    if (MODE >= 2) { g = a.in[23] + l * 1024; bb = a.in[24] + l * 1024; }
    if (MODE == 0 || MODE == 2) {
        const float* win = a.in[1] + (size_t)(MODE == 0 ? 0 : l + 1) * DMOD * INTOT + 3584;
        __syncthreads();
        for (int e = F_TID; e < 8192; e += 512) { const int k = e >> 3, j = e & 7; wfx[j * 1024 + k] = win[(size_t)k * INTOT + j]; }
        __syncthreads();
    }
    const float* src = (MODE == 0) ? a.in[0] : (const float*)(F.ws + WS_PRE);
    const int gw = F.vcu * 8 + F_WAVE, NGW = F.G * 8;
    for (int m = gw; m < M; m += NGW) {
        const f32x4* xr = (const f32x4*)(src + (size_t)m * 1024) + F_LANE;
        f32x4 v[4];
#pragma unroll
        for (int j = 0; j < 4; ++j) v[j] = xr[64 * j];
        if (MODE != 0) {
            float s = 0.f;
#pragma unroll
            for (int j = 0; j < 4; ++j) s += (v[j].x + v[j].y) + (v[j].z + v[j].w);
            const float mean = wave_sum(s) * (1.f / 1024.f); float s2 = 0.f;
#pragma unroll
            for (int j = 0; j < 4; ++j) { v[j] = v[j] - mean; s2 += (v[j].x * v[j].x + v[j].y * v[j].y) + (v[j].z * v[j].z + v[j].w * v[j].w); }
            const float rstd = 1.f / sqrtf(wave_sum(s2) * (1.f / 1024.f) + LN_EPS);
#pragma unroll
            for (int j = 0; j < 4; ++j) { const f32x4 gg = ((const f32x4*)g)[64 * j + F_LANE], bv = ((const f32x4*)bb)[64 * j + F_LANE]; v[j] = v[j] * rstd * gg + bv; }
        }
        if (MODE == 1) {
            f32x4* o = (f32x4*)(F.ws + WS_PRE + (size_t)m * 4096) + F_LANE;
#pragma unroll
            for (int j = 0; j < 4; ++j) o[64 * j] = v[j];
            v2u* ob = (v2u*)(F.ws + WS_H1B + (size_t)m * 2048) + F_LANE;
#pragma unroll
            for (int j = 0; j < 4; ++j) { v2u w; w.x = pk2(v[j].x, v[j].y); w.y = pk2(v[j].z, v[j].w); ob[64 * j] = w; }
        } else if (MODE == 3) {
            f32x4* o = (f32x4*)(a.out + (size_t)m * 1024) + F_LANE;
#pragma unroll
            for (int j = 0; j < 4; ++j) o[64 * j] = v[j];
        } else {
            v2u* ob = (v2u*)(F.ws + WS_HB + (size_t)m * 2048) + F_LANE;
            v2u* ol = (v2u*)(F.ws + WS_HBL + (size_t)m * 2048) + F_LANE;
#pragma unroll
            for (int j = 0; j < 4; ++j) { v2u w; w.x = pk2(v[j].x, v[j].y); w.y = pk2(v[j].z, v[j].w); ob[64 * j] = w;
                if (MODE == 2) { v2u wl; wl.x = pk2(v[j].x - bflo(w.x), v[j].y - bfhi(w.x)); wl.y = pk2(v[j].z - bflo(w.y), v[j].w - bfhi(w.y)); ol[64 * j] = wl; } }
            float mine = 0.f;
#pragma unroll 1
            for (int c = 0; c < 8; ++c) { float s = 0.f;
#pragma unroll
                for (int j = 0; j < 4; ++j) { const f32x4 w = *(const f32x4*)(wfx + c * 1024 + 256 * j + 4 * F_LANE); s += (v[j].x * w.x + v[j].y * w.y) + (v[j].z * w.z + v[j].w * w.w); }
                s = wave_sum(s); if (F_LANE == c) mine = s; }
            if (F_LANE < 8) ((float*)(F.ws + WS_MISC + MISC_FXF))[(size_t)m * 8 + F_LANE] = mine;
        }
    }
}

template <int MT, int NT> __device__ __forceinline__ void mma_lds(f32x4 (&acc)[MT][NT], const u16* sA, int lda, const u16* sB, int ldb, int K, int lane) {
    const int r = lane & 15, q = lane >> 4;
    for (int k0 = 0; k0 < K; k0 += 32) {
        bf16x8 av[MT], bv[NT];
#pragma unroll
        for (int mt = 0; mt < MT; ++mt) av[mt] = *(const bf16x8*)(sA + (mt * 16 + r) * lda + k0 + q * 8);
#pragma unroll
        for (int nt = 0; nt < NT; ++nt) bv[nt] = *(const bf16x8*)(sB + (nt * 16 + r) * ldb + k0 + q * 8);
#pragma unroll
        for (int mt = 0; mt < MT; ++mt)
#pragma unroll
            for (int nt = 0; nt < NT; ++nt) acc[mt][nt] = __builtin_amdgcn_mfma_f32_16x16x32_bf16(av[mt], bv[nt], acc[mt][nt], 0, 0, 0);
    }
}

__device__ __forceinline__ void hgrn_load_scan(const float* ZF, int row0, int h, float* LG, float* KK, float* QT, int tid) {
    for (int idx = tid; idx < 64 * 32; idx += 512) { const int t = idx >> 5, k4 = (idx & 31) * 4;
        const f32x4 lf = *(const f32x4*)(ZF + (size_t)(row0 + t) * 512 + h * 128 + k4);
        *(f32x4*)(LG + t * 128 + k4) = lf;
        f32x4 kk; kk[0] = 1.f - __expf(lf[0]); kk[1] = 1.f - __expf(lf[1]); kk[2] = 1.f - __expf(lf[2]); kk[3] = 1.f - __expf(lf[3]);
        *(f32x4*)(KK + t * 128 + k4) = kk; }
    __syncthreads();
    const int k = tid & 127, q = tid >> 7; float run = 0.f;
    for (int t = 16 * q; t < 16 * q + 16; ++t) { run += LG[t * 128 + k]; LG[t * 128 + k] = run; }
    QT[q * 128 + k] = run;
    __syncthreads();
}
__device__ __forceinline__ void load_vT(const u16* ZI, int row0, int h, u16* BT, int tid) {
    for (int idx = tid; idx < 1024; idx += 512) { const int s = idx & 63, v8 = (idx >> 6) * 8;
        const v4u e = *(const v4u*)(ZI + (size_t)(row0 + s) * 512 + h * 128 + v8);
        BT[(v8 + 0) * 72 + s] = (u16)(e.x & 0xffff); BT[(v8 + 1) * 72 + s] = (u16)(e.x >> 16); BT[(v8 + 2) * 72 + s] = (u16)(e.y & 0xffff); BT[(v8 + 3) * 72 + s] = (u16)(e.y >> 16);
        BT[(v8 + 4) * 72 + s] = (u16)(e.z & 0xffff); BT[(v8 + 5) * 72 + s] = (u16)(e.z >> 16); BT[(v8 + 6) * 72 + s] = (u16)(e.w & 0xffff); BT[(v8 + 7) * 72 + s] = (u16)(e.w >> 16); }
}
__device__ __forceinline__ void hgrn_a_unit(const Frame& F, int u) {
    const int b = u >> 7, h = (u >> 5) & 3, c = u & 31, row0 = b * SEQL + c * 64, tid = F_TID, lane = F_LANE, w = F_WAVE;
    float* LG = (float*)F.lds; float* KK = (float*)(F.lds + 32768); float* QT = (float*)(F.lds + 65536);
    u16* AT = (u16*)(F.lds + 67584); u16* BT = (u16*)(F.lds + 67584 + 18432);
    hgrn_load_scan((const float*)(F.ws + WS_ZF), row0, h, LG, KK, QT, tid);
    load_vT((const u16*)(F.ws + WS_ZI), row0, h, BT, tid);
    { const int k = tid & 127, q = tid >> 7; float off = 0.f, glast = 0.f;
#pragma unroll
      for (int qq = 0; qq < 4; ++qq) { const float t_ = QT[qq * 128 + k]; glast += t_; if (qq < q) off += t_; }
      for (int s = 16 * q; s < 16 * q + 16; ++s) { const float gg = LG[s * 128 + k] + off; AT[k * 72 + s] = (u16)f2bf(KK[s * 128 + k] * __expf(glast - gg)); }
      if (q == 0) ((float*)(F.ws + WS_MISC + MISC_DEC))[u * 128 + k] = __expf(glast); }
    __syncthreads();
    f32x4 acc[2][4];
#pragma unroll
    for (int i = 0; i < 2; ++i)
#pragma unroll
        for (int j = 0; j < 4; ++j) acc[i][j] = (f32x4){0.f, 0.f, 0.f, 0.f};
    mma_lds<2, 4>(acc, AT + ((w >> 1) * 32) * 72, 72, BT + ((w & 1) * 64) * 72, 72, 64, lane);
    u16* KV = (u16*)(F.ws + WS_KV) + (size_t)u * 16384;
#pragma unroll
    for (int mt = 0; mt < 2; ++mt)
#pragma unroll
        for (int nt = 0; nt < 4; ++nt) { const int k0 = (w >> 1) * 32 + mt * 16 + (lane >> 4) * 4, v = (w & 1) * 64 + nt * 16 + (lane & 15);
            v2u o; o.x = pk2(acc[mt][nt][0], acc[mt][nt][1]); o.y = pk2(acc[mt][nt][2], acc[mt][nt][3]); *(v2u*)(KV + v * 128 + k0) = o; }
    __syncthreads();
}
__device__ __forceinline__ void hgrn_scan(const Frame& F) {
    const float* DEC = (const float*)(F.ws + WS_MISC + MISC_DEC);
    for (int gid = blockIdx.x * 512 + F_TID; gid < 32 * 4096; gid += F.G * 512) {
        const int bh = gid >> 12, e = (gid & 4095) * 4, k = e & 127;
        float s0 = 0.f, s1 = 0.f, s2 = 0.f, s3 = 0.f;
        u16* p = (u16*)(F.ws + WS_KV) + (size_t)bh * 32 * 16384 + e;
        const float* dp = DEC + (size_t)bh * 32 * 128 + k;
#pragma unroll 4
        for (int c = 0; c < 32; ++c) { const v2u kv = *(const v2u*)(p + (size_t)c * 16384); const f32x4 d = *(const f32x4*)(dp + c * 128);
            v2u o; o.x = pk2(s0, s1); o.y = pk2(s2, s3); *(v2u*)(p + (size_t)c * 16384) = o;
            s0 = d[0] * s0 + bflo(kv.x); s1 = d[1] * s1 + bfhi(kv.x); s2 = d[2] * s2 + bflo(kv.y); s3 = d[3] * s3 + bfhi(kv.y); }
    }
}
__device__ __forceinline__ void hgrn_c_unit(const Frame& F, const Args& a, int l, int u) {
    const int b = u >> 7, h = (u >> 5) & 3, c = u & 31, row0 = b * SEQL + c * 64, tid = F_TID, lane = F_LANE, w = F_WAVE;
    float* LG = (float*)F.lds; float* KK = (float*)(F.lds + 32768); float* QT = (float*)(F.lds + 65536);
    u16* ST = (u16*)F.lds; u16* BT = (u16*)(F.lds + 34816); u16* PP = (u16*)(F.lds + 53248);
    u16* QE = (u16*)(F.lds + 67584); u16* KE = (u16*)(F.lds + 84992); float* RS = (float*)(F.lds + 102400);
    hgrn_load_scan((const float*)(F.ws + WS_ZF), row0, h, LG, KK, QT, tid);
    { const int k = tid & 127, q = tid >> 7; float off = 0.f;
#pragma unroll
      for (int qq = 0; qq < 4; ++qq) { const float t_ = QT[qq * 128 + k]; if (qq < q) off += t_; }
      const u16* ZQ = (const u16*)(F.ws + WS_ZQ) + (size_t)row0 * 512 + h * 128 + k;
      for (int t = 16 * q; t < 16 * q + 16; ++t) { const float gg = LG[t * 128 + k] + off; const float qv = bf2f(ZQ[(size_t)t * 512]);
          QE[t * 136 + k] = (u16)f2bf(qv * __expf(gg)); KE[t * 136 + k] = (u16)f2bf(KK[t * 128 + k] * __expf(fminf(-gg, 80.f))); } }
    __syncthreads();
    { const u16* KV = (const u16*)(F.ws + WS_KV) + (size_t)u * 16384;
      for (int idx = tid; idx < 2048; idx += 512) { const int v = idx >> 4, k8 = (idx & 15) * 8; *(v4u*)(ST + v * 136 + k8) = *(const v4u*)(KV + v * 128 + k8); } }
    load_vT((const u16*)(F.ws + WS_ZI), row0, h, BT, tid);
    const int mt = w >> 1;
    { f32x4 sc[1][2]; sc[0][0] = (f32x4){0.f, 0.f, 0.f, 0.f}; sc[0][1] = (f32x4){0.f, 0.f, 0.f, 0.f};
      const int nt0 = (w & 1) * 2;
      mma_lds<1, 2>(sc, QE + mt * 16 * 136, 136, KE + nt0 * 16 * 136, 136, 128, lane);
#pragma unroll
      for (int i = 0; i < 2; ++i)
#pragma unroll
          for (int j = 0; j < 4; ++j) { const int t = mt * 16 + (lane >> 4) * 4 + j, s = (nt0 + i) * 16 + (lane & 15); PP[t * 72 + s] = (u16)f2bf(s <= t ? sc[0][i][j] : 0.f); } }
    __syncthreads();
    f32x4 acc[1][4];
#pragma unroll
    for (int i = 0; i < 4; ++i) acc[0][i] = (f32x4){0.f, 0.f, 0.f, 0.f};
    mma_lds<1, 4>(acc, QE + mt * 16 * 136, 136, ST + ((w & 1) * 64) * 136, 136, 128, lane);
    mma_lds<1, 4>(acc, PP + mt * 16 * 72, 72, BT + ((w & 1) * 64) * 72, 72, 64, lane);
#pragma unroll
    for (int j = 0; j < 4; ++j) { float ss = 0.f;
#pragma unroll
        for (int i = 0; i < 4; ++i) ss += acc[0][i][j] * acc[0][i][j];
        ss += __shfl_xor(ss, 1); ss += __shfl_xor(ss, 2); ss += __shfl_xor(ss, 4); ss += __shfl_xor(ss, 8);
        if ((lane & 15) == 0) RS[(mt * 16 + (lane >> 4) * 4 + j) * 2 + (w & 1)] = ss; }
    __syncthreads();
    const float* nw = a.in[3] + l * 128;
#pragma unroll
    for (int j = 0; j < 4; ++j) { const int t = mt * 16 + (lane >> 4) * 4 + j; const float r = rsqrtf((RS[t * 2] + RS[t * 2 + 1]) * (1.f / 128.f) + RMS_EPS);
        const size_t ro = (size_t)(row0 + t) * 512 + h * 128;
#pragma unroll
        for (int i = 0; i < 4; ++i) { const int v = (w & 1) * 64 + i * 16 + (lane & 15); const float gt = bf2f(((const u16*)(F.ws + WS_ZG))[ro + v]);
            ((u16*)(F.ws + WS_YA))[ro + v] = (u16)f2bf(acc[0][i][j] * r * nw[v] * gt * sigm(gt)); } }
    __syncthreads();
}

__device__ __forceinline__ void load_tile16(u16* dst, int dpitch, const u16* src, size_t spitch, int rows, int cols8, int tid) {
    for (int idx = tid; idx < rows * cols8; idx += 512) { const int r = idx / cols8, c8 = idx - r * cols8; *(v4u*)(dst + r * dpitch + c8 * 8) = *(const v4u*)(src + (size_t)r * spitch + c8 * 8); }
}
__device__ __forceinline__ void s5_1_unit(const Frame& F, int unit) {
    const int g = unit >> 3, rt = unit & 7, tid = F_TID, lane = F_LANE, w = F_WAVE;
    u16* A = (u16*)F.lds; u16* B = (u16*)(F.lds + 67584);
    load_tile16(A, 264, (const u16*)(F.ws + WS_SU) + ((size_t)g * 1024 + rt * 128) * 256, 256, 128, 32, tid);
    load_tile16(B, 264, (const u16*)(F.dout + DO_EM) + (size_t)g * 128 * 256, 256, 128, 32, tid);
    __syncthreads();
    f32x4 acc[2][4];
#pragma unroll
    for (int i = 0; i < 2; ++i)
#pragma unroll
        for (int j = 0; j < 4; ++j) acc[i][j] = (f32x4){0.f, 0.f, 0.f, 0.f};
    mma_lds<2, 4>(acc, A + ((w >> 1) * 32) * 264, 264, B + ((w & 1) * 64) * 264, 264, 256, lane);
    u16* SE = (u16*)(F.ws + WS_SE);
#pragma unroll
    for (int mt = 0; mt < 2; ++mt)
#pragma unroll
        for (int nt = 0; nt < 4; ++nt)
#pragma unroll
            for (int j = 0; j < 4; ++j) { const int n = rt * 128 + (w >> 1) * 32 + mt * 16 + (lane >> 4) * 4 + j, r = (w & 1) * 64 + nt * 16 + (lane & 15);
                SE[((size_t)n * 32 + g) * 128 + r] = (u16)f2bf(acc[mt][nt][j]); }
    __syncthreads();
}
__device__ __forceinline__ void s5_scan(const Frame& F) {
    if (F_WAVE != 0) return;
    const float2* LAM = (const float2*)(F.dout + DO_LAM);
    for (int gl = blockIdx.x * 64 + F_LANE; gl < 8 * 32 * 64; gl += F.G * 64) {
        const int b = gl >> 11, g = (gl >> 6) & 31, p = gl & 63; const float2 lm = LAM[g * 64 + p];
        u16* base = (u16*)(F.ws + WS_SE) + ((size_t)(b * 128) * 32 + g) * 128 + p;
        float sr = 0.f, si = 0.f;
        for (int c0 = 0; c0 < 128; c0 += 8) {
            float er[8], ei[8];
#pragma unroll
            for (int i = 0; i < 8; ++i) { const u16* q = base + (size_t)(c0 + i) * 4096; er[i] = bf2f(q[0]); ei[i] = bf2f(q[64]); }
#pragma unroll
            for (int i = 0; i < 8; ++i) { u16* q = base + (size_t)(c0 + i) * 4096; q[0] = (u16)f2bf(sr); q[64] = (u16)f2bf(si);
                const float nr = lm.x * sr - lm.y * si + er[i], ni = lm.x * si + lm.y * sr + ei[i]; sr = nr; si = ni; }
        }
    }
}
__device__ __forceinline__ void s5_2_unit(const Frame& F, int unit) {
    const int g = unit >> 3, rt = unit & 7, tid = F_TID, lane = F_LANE, w = F_WAVE;
    u16* A = (u16*)F.lds; u16* B = (u16*)(F.lds + 34816);
    f32x4 acc[2][8];
#pragma unroll
    for (int i = 0; i < 2; ++i)
#pragma unroll
        for (int j = 0; j < 8; ++j) acc[i][j] = (f32x4){0.f, 0.f, 0.f, 0.f};
    for (int kc = 0; kc < 3; ++kc) {
        __syncthreads();
        if (kc < 2) load_tile16(A, 136, (const u16*)(F.ws + WS_SU) + ((size_t)g * 1024 + rt * 128) * 256 + kc * 128, 256, 128, 16, tid);
        else        load_tile16(A, 136, (const u16*)(F.ws + WS_SE) + ((size_t)(rt * 128) * 32 + g) * 128, 4096, 128, 16, tid);
        load_tile16(B, 136, (const u16*)(F.dout + DO_TM) + (size_t)g * 256 * 384 + kc * 128, 384, 256, 16, tid);
        __syncthreads();
        mma_lds<2, 8>(acc, A + ((w >> 1) * 32) * 136, 136, B + ((w & 1) * 128) * 136, 136, 128, lane);
    }
    u16* YG = (u16*)(F.dout + DO_YG);
#pragma unroll
    for (int mt = 0; mt < 2; ++mt)
#pragma unroll
        for (int nt = 0; nt < 8; ++nt)
#pragma unroll
            for (int j = 0; j < 4; ++j) { const int n = rt * 128 + (w >> 1) * 32 + mt * 16 + (lane >> 4) * 4 + j, i = (w & 1) * 8 + nt, hp = lane & 15;
                const float y = acc[mt][nt][j]; const float z = 0.7978845608028654f * (y + 0.044715f * y * y * y);
                const float th = 1.f - 2.f / (__expf(2.f * z) + 1.f);
                YG[((size_t)n * 16 + i) * 512 + 16 * g + hp] = (u16)f2bf(0.5f * y * (1.f + th)); }
    __syncthreads();
}

#ifndef REP_MIX
#define REP_MIX 1
#endif
#ifndef REP_SYNC
#define REP_SYNC 1
#endif
#ifndef REP_G1
#define REP_G1 1
#endif
#define GSYNC() do { for (int rs_ = 0; rs_ < REP_SYNC; ++rs_) xcd_barrier(xbar); } while (0)
__global__ void __launch_bounds__(512, 2) mega_fwd(Args a) {
    extern __shared__ __attribute__((aligned(16))) unsigned char lds[];
    cg::grid_group grid = cg::this_grid();
    Frame F; F.lds = lds; F.ws = a.ws; F.dout = (unsigned char*)a.out;
    F.G = gridDim.x; { const int bx = blockIdx.x; F.vcu = (F.G % 8 == 0) ? (bx % 8) * (F.G / 8) + bx / 8 : bx; }
    PG8_LAS unsigned char* glds = (PG8_LAS unsigned char*)lds;
    typedef pg8::bf16_t pb;
    unsigned char* ws = a.ws; unsigned char* dq = F.dout;

    unsigned* barw = (unsigned*)(ws + WS_MISC + 3 * MiB);
    volatile LAS unsigned* xst = (volatile LAS unsigned*)((LAS unsigned char*)lds + 147392);
    if (threadIdx.x < 16) xst[threadIdx.x] = 0u;
    if (blockIdx.x == 0) for (int i = threadIdx.x; i < XCD_BAR_WORDS; i += 512) barw[i] = 0u;
    if (blockIdx.x == 0) { float* LB = (float*)(ws + WS_MISC + MISC_LB);
        for (int k = F_TID; k < 512; k += 512) { const float a0 = a.in[2][k], a1 = a.in[2][512 + k], mx = fmaxf(a0, a1), e0 = expf(a0 - mx), e1 = expf(a1 - mx); LB[k] = 0.f; LB[512 + k] = e1 / (e0 + e1); } }
#ifndef NO_PRO
    convert_weights(F, a, 0);
    s5_mats(F, a, 0);
#endif
#ifndef NO_ROW
    row_pass<0>(F, a, 0);
#endif
    grid.sync();
    const XcdBarrier xbar = xcd_barrier_post(barw, xst);

    for (int l = 0; l < 2; ++l) {
#ifndef NO_GEMM
        { pg8::Gemm g{(const pb*)(ws + WS_HB), (const pb*)(dq + DO_WIN), M, 4096, 1024}; pg8::StaticOrder S; S.init(M, 4096, F.G, (int)blockIdx.x);
          pg8::EpiIn E{ws, (const float*)(ws + WS_MISC + MISC_LB) + l * 512, attn_body::C2};
          for (int rep_ = 0; rep_ < REP_G1; ++rep_) pg8::gemm_phase<pg8::EpiIn, pg8::StaticOrder, true, true>(glds, g, S, E); }
#endif
        GSYNC();
#ifndef NO_ATTN
        { const attn_body::AttnTensors AT{(const attn_body::bf16*)(ws + WS_FQ), (const attn_body::bf16*)(ws + WS_FK), (const attn_body::bf16*)(ws + WS_FV), (attn_body::bf16*)(ws + WS_YB),
                                          (const float*)(ws + WS_MISC + MISC_FXF), a.in[4] + l * 8};
          const attn_body::StaticOrder S((int)F.G, (int)blockIdx.x);
          attn_body::attn_phase<attn_body::StaticOrder>((char*)lds, AT, S); }
#endif
        __syncthreads();
#ifndef NO_MIX
        for (int rep_ = 0; rep_ < REP_MIX; ++rep_) {
        for (int u = F.vcu; u < 1024; u += F.G) hgrn_a_unit(F, u);
        for (int u = F.vcu; u < 256; u += F.G) s5_1_unit(F, u);
        }
#endif
        GSYNC();
#ifndef NO_MIX
        hgrn_scan(F);
        s5_scan(F);
#endif
        GSYNC();
#ifndef NO_MIX
        for (int rep_ = 0; rep_ < REP_MIX; ++rep_) {
        for (int u = F.vcu; u < 1024; u += F.G) hgrn_c_unit(F, a, l, u);
        for (int u = F.vcu; u < 256; u += F.G) s5_2_unit(F, u);
        }
#endif
        GSYNC();
#ifndef NO_GEMM2
        { pg8::Gemm g{(const pb*)(dq + DO_YG), (const pb*)(dq + DO_WGLU), M, 512, 512}; pg8::StaticOrder S; S.init(M, 512, F.G, (int)blockIdx.x);
          pg8::EpiGlu E{(const pb*)(dq + DO_YG), (pb*)(ws + WS_YC)};
          pg8::gemm_phase<pg8::EpiGlu, pg8::StaticOrder, true, true>(glds, g, S, E); }
        { pg8::Gemm g{(const pb*)(ws + WS_HB), (const pb*)(dq + DO_WIN) + (size_t)4096 * 1024, M, 3072, 1024}; pg8::StaticOrder S; S.init(M, 3072, F.G, (int)blockIdx.x);
          pg8::EpiGate E{(pb*)(ws + WS_GATES)};
          pg8::gemm_phase<pg8::EpiGate, pg8::StaticOrder, true, true>(glds, g, S, E); }
        GSYNC();
        { pg8::Gemm g{(const pb*)(ws + WS_YA), (const pb*)(dq + DO_WBR), 3 * M, 3072, 512}; pg8::BranchOrder S; S.init(F.G, (int)blockIdx.x);
          pg8::EpiBranch E{(const pb*)(ws + WS_GATES), (pb*)(ws + WS_MERGED)};
          pg8::gemm_phase<pg8::EpiBranch, pg8::BranchOrder, true, true>(glds, g, S, E); }
        GSYNC();
        { pg8::Gemm g{(const pb*)(ws + WS_MERGED), (const pb*)(dq + DO_WOUT), M, 1024, 1024}; pg8::StaticOrder S; S.init(M, 1024, F.G, (int)blockIdx.x);
          pg8::EpiRes E{l == 0 ? a.in[0] : nullptr, (const pb*)(ws + WS_HB), (const pb*)(ws + WS_HBL), (float*)(ws + WS_PRE)};
          pg8::gemm_phase<pg8::EpiRes, pg8::StaticOrder, true, true>(glds, g, S, E); }
        GSYNC();
#endif
#ifndef NO_ROW
        row_pass<1>(F, a, l);
#endif
        GSYNC();
#ifndef NO_GEMM3
        { pg8::Gemm g{(const pb*)(ws + WS_H1B), (const pb*)(dq + DO_WGU), M, 5632, 1024}; pg8::StaticOrder S; S.init(M, 5632, F.G, (int)blockIdx.x);
          pg8::EpiSwiglu E{(pb*)(ws + WS_FFH)};
          for (int rep_ = 0; rep_ < REP_G1; ++rep_) pg8::gemm_phase<pg8::EpiSwiglu, pg8::StaticOrder, true, true>(glds, g, S, E); }
        GSYNC();
        { pg8::Gemm g{(const pb*)(ws + WS_FFH), (const pb*)(dq + DO_WDN), M, 1024, FFN_H}; pg8::StaticOrder S; S.init(M, 1024, F.G, (int)blockIdx.x);
          pg8::EpiRes E{(const float*)(ws + WS_PRE), nullptr, nullptr, (float*)(ws + WS_PRE)};
          pg8::gemm_phase<pg8::EpiRes, pg8::StaticOrder, true, true>(glds, g, S, E); }
        GSYNC();
#endif
        if (l == 0) {
#ifndef NO_PRO
            convert_weights(F, a, 1); s5_mats(F, a, 1);
#endif
#ifndef NO_ROW
            row_pass<2>(F, a, 0);
#endif
            GSYNC(); }
#ifndef NO_ROW
        else row_pass<3>(F, a, 1);
#endif
    }
}

extern "C" void kernel_launch(void* const* d_in, const int* in_sizes, int n_in, void* d_out, int out_size, void* d_ws, size_t ws_size, hipStream_t stream) {
    static int grid = 0;
    if (grid == 0) {
        int dev = 0, cus = 0, per_cu = 0;
        if (hipGetDevice(&dev) != hipSuccess || hipDeviceGetAttribute(&cus, hipDeviceAttributeMultiprocessorCount, dev) != hipSuccess) { fprintf(stderr, "kernel_launch: device query failed\n"); grid = -1; return; }
        if (hipFuncSetAttribute((const void*)mega_fwd, hipFuncAttributeMaxDynamicSharedMemorySize, LDS_BYTES) != hipSuccess) { fprintf(stderr, "kernel_launch: hipFuncSetAttribute failed\n"); grid = -1; return; }
        if (hipOccupancyMaxActiveBlocksPerMultiprocessor(&per_cu, (const void*)mega_fwd, 512, LDS_BYTES) != hipSuccess || per_cu < 1) { fprintf(stderr, "kernel_launch: occupancy query says %d blocks per CU\n", per_cu); grid = -1; return; }
        grid = cus;
        if (n_in != 25 || out_size != M * DMOD || ws_size < 256 * MiB) { fprintf(stderr, "kernel_launch: unexpected shapes (n_in %d out %d ws %zu)\n", n_in, out_size, ws_size); grid = -1; return; }
    }
    if (grid < 0) return;
    Args a{};
    for (int i = 0; i < 25; ++i) a.in[i] = (const float*)d_in[i];
    a.out = (float*)d_out; a.ws = (unsigned char*)d_ws;
    void* args[] = {&a};
    hipError_t e = hipLaunchCooperativeKernel((void*)mega_fwd, dim3(grid), dim3(512), args, LDS_BYTES, stream);
    if (e != hipSuccess) fprintf(stderr, "kernel_launch: cooperative launch failed: %s (grid %d)\n", hipGetErrorString(e), grid);
}
```

```cpp
#include <hip/hip_runtime.h>
#include <hip/hip_cooperative_groups.h>
#include <cstdio>
#include <cstdint>
namespace cg = cooperative_groups;

namespace pg8 {
#define PG8_LAS __attribute__((address_space(3)))
typedef unsigned short bf16_t;
typedef short bf16x8 __attribute__((ext_vector_type(8)));
typedef float f32x4 __attribute__((ext_vector_type(4)));
typedef unsigned u32x4 __attribute__((ext_vector_type(4)));
constexpr int BM = 256, BK = 64, HALF = 128, HTB = HALF * BK * 2  , STAGE_BYTES = 8 * HTB, NXCD = 8, WGM = 8;

__host__ __device__ __forceinline__ int lds_byte(int r, int c) { const int st = (r >> 4) * 2 + (c >> 5), rr = r & 15, cc = c & 31, ob = rr * 64 + cc * 2; return st * 1024 + (ob ^ (((ob >> 9) & 1) << 5)); }
__host__ __device__ __forceinline__ void stage_rc(int b, int& R, int& C) { const int st = b / 1024, sb = b % 1024, swz = sb ^ (((sb >> 9) & 1) << 5); R = (st >> 1) * 16 + swz / 64; C = (st & 1) * 32 + (swz % 64) / 2; }
__host__ __device__ __forceinline__ int perm32(int rho) { const int n = rho >> 4, i = rho & 15; return 8 * (i >> 2) + 4 * n + (i & 3); }

struct Unit { int pm, pn; };
struct Gemm { const bf16_t* A; const bf16_t* Bt; int M, N, K; };

struct StaticOrder {
    int nM, nN, nwg, G, c;
    __host__ __device__ void init(int M, int N, int G_, int c_) { nM = M / BM; nN = N / BM; nwg = nM * nN; G = G_; c = c_; }
    __host__ __device__ bool next(int i, Unit& u) const {
        const long L = (long)i * G + c; if (L >= nwg) return false;
        int wgid = (int)L; { const int q = nwg / NXCD, r = nwg % NXCD, xcd = wgid % NXCD, off = wgid / NXCD; wgid = (xcd < r ? xcd * (q + 1) : r * (q + 1) + (xcd - r) * q) + off; }
        const int nig = WGM * nN, gid = wgid / nig, fm = gid * WGM, gsz = (nM - fm) < WGM ? (nM - fm) : WGM;
        u.pm = fm + ((wgid % nig) % gsz); u.pn = (wgid % nig) / gsz; return true;
    }
    __device__ __forceinline__ void a_ready(const Unit&) const {}
    __device__ __forceinline__ void done(const Unit&) const {}
};

__device__ __forceinline__ unsigned cvt_pk_bf16(float lo, float hi) { unsigned r; asm volatile("v_cvt_pk_bf16_f32 %0, %1, %2" : "=v"(r) : "v"(lo), "v"(hi)); return r; }
typedef float f32x2 __attribute__((ext_vector_type(2)));

template <class Epi, class Sched, bool ALIGN_EPI = false, bool SP2 = false>
__device__ __forceinline__ void gemm_phase(PG8_LAS unsigned char* lds, const Gemm g, const Sched& S, const Epi& E) {
    int tid_o = threadIdx.x; asm volatile("" : "+v"(tid_o));
    const int tid = tid_o, wid = __builtin_amdgcn_readfirstlane(tid >> 6), lane = tid & 63, wr = wid >> 2, wc = wid & 3, fr = lane & 15, fq = lane >> 4;
    const int K = g.K, nt = K / BK;
    unsigned voffA[2], voffB[2];
#pragma unroll
    for (int i = 0; i < 2; ++i) { int R, C; stage_rc(tid * 16 + i * 8192, R, C); const int Rb = Epi::PERM ? ((R & ~31) + perm32(R & 31)) : R;
        voffA[i] = (unsigned)(R * K + C) * 2u; voffB[i] = (unsigned)(Rb * K + C) * 2u; }
    const size_t kstep = (size_t)(BK * 2);
    const size_t hstep = (size_t)HALF * K * 2;
    const size_t tstep = 2 * hstep;
    const unsigned ldsw = (unsigned)wid * 1024u;
    const int aoff = lds_byte(wr * 64 + fr, fq * 8), boff = lds_byte(wc * 32 + fr, fq * 8);
#define PG8_SA(b, h) (((b) * 2 + (h)) * HTB)
#define PG8_SB(b, h) ((4 + (b) * 2 + (h)) * HTB)
#define PG8_STAGE(bufoff, gbase, voff) do { _Pragma("unroll") for (int _i = 0; _i < 2; ++_i) \
        __builtin_amdgcn_global_load_lds((const unsigned*)((const char*)(gbase) + (voff)[_i]), (PG8_LAS unsigned*)(lds + (bufoff) + ldsw + _i * 8192), 16, 0, 0); } while (0)
#define PG8_LDA(dst, b, h) do { _Pragma("unroll") for (int m = 0; m < 4; ++m) _Pragma("unroll") for (int k = 0; k < 2; ++k) dst[m][k] = *(const PG8_LAS bf16x8*)(lds + PG8_SA(b, h) + aoff + m * 2048 + k * 1024); } while (0)
#define PG8_LDB(dst, b, h) do { _Pragma("unroll") for (int n = 0; n < 2; ++n) _Pragma("unroll") for (int k = 0; k < 2; ++k) dst[n][k] = *(const PG8_LAS bf16x8*)(lds + PG8_SB(b, h) + boff + n * 2048 + k * 1024); } while (0)
#define PG8_MMA(ai, bj, At, Bt) do { __builtin_amdgcn_s_setprio(1); _Pragma("unroll") for (int m = 0; m < 4; ++m) _Pragma("unroll") for (int n = 0; n < 2; ++n) _Pragma("unroll") for (int k = 0; k < 2; ++k) \
        acc[ai][bj][m][n] = __builtin_amdgcn_mfma_f32_16x16x32_bf16(Bt[n][k], At[m][k], acc[ai][bj][m][n], 0, 0, 0); __builtin_amdgcn_s_setprio(0); } while (0)
#define PG8_WAIT_V(n) asm volatile("s_waitcnt vmcnt(" #n ")" ::: "memory")
#define PG8_WAIT_L(n) asm volatile("s_waitcnt lgkmcnt(" #n ")" ::: "memory")
#define PG8_BAR __builtin_amdgcn_s_barrier()
#define PG8_SCHED __builtin_amdgcn_sched_barrier(0)
    Unit cur, nxt; int ui = 0;
    if (!S.next(0, cur)) return;
    f32x4 acc[2][2][4][2];
#pragma unroll
    for (int a = 0; a < 2; ++a)
#pragma unroll
        for (int b = 0; b < 2; ++b)
#pragma unroll
            for (int m = 0; m < 4; ++m)
#pragma unroll
                for (int n = 0; n < 2; ++n) acc[a][b][m][n] = (f32x4){0.f, 0.f, 0.f, 0.f};
    bf16x8 At[4][2], B0[2][2], B1[2][2];
    const char* cA = (const char*)g.A + (size_t)cur.pm * tstep; const char* cB = (const char*)g.Bt + (size_t)cur.pn * tstep;
    S.a_ready(cur);
    if constexpr (SP2) {
        PG8_STAGE(PG8_SB(0, 0), cB, voffB); PG8_STAGE(PG8_SB(0, 1), cB + hstep, voffB); PG8_STAGE(PG8_SA(0, 0), cA, voffA); PG8_STAGE(PG8_SA(0, 1), cA + hstep, voffA);
        if (wr == 1) PG8_BAR;
        PG8_WAIT_V(2); PG8_BAR;
        PG8_STAGE(PG8_SB(1, 0), cB + kstep, voffB); PG8_STAGE(PG8_SA(1, 0), cA + kstep, voffA); PG8_STAGE(PG8_SB(1, 1), cB + hstep + kstep, voffB);
        PG8_WAIT_V(6); PG8_BAR;
    } else {
        PG8_STAGE(PG8_SB(0, 0), cB, voffB); PG8_STAGE(PG8_SA(0, 0), cA, voffA); PG8_STAGE(PG8_SB(0, 1), cB + hstep, voffB); PG8_STAGE(PG8_SA(0, 1), cA + hstep, voffA);
        if (wr == 1) PG8_BAR;
        PG8_WAIT_V(4); PG8_BAR;
        PG8_STAGE(PG8_SB(1, 0), cB + kstep, voffB); PG8_STAGE(PG8_SA(1, 0), cA + kstep, voffA); PG8_STAGE(PG8_SB(1, 1), cB + hstep + kstep, voffB);
        PG8_WAIT_V(6); PG8_BAR;
    }
    for (;;) {
        const bool has_next = S.next(ui + 1, nxt);
        const char* nA = has_next ? (const char*)g.A + (size_t)nxt.pm * tstep : cA; const char* nB = has_next ? (const char*)g.Bt + (size_t)nxt.pn * tstep : cB;
        for (int t = 0; t < nt; t += 2) {
            const bool last = (t == nt - 2);
            const char* a1 = cA + (size_t)(t + 1) * kstep;
            const char* a2 = last ? nA : cA + (size_t)(t + 2) * kstep; const char* b2 = last ? nB : cB + (size_t)(t + 2) * kstep;
            const char* a3 = a2 + kstep; const char* b3 = b2 + kstep;
            if (last && has_next) S.a_ready(nxt);
            if constexpr (SP2) {
            PG8_LDB(B0, 0, 0); PG8_LDB(B1, 0, 1); PG8_SCHED; PG8_LDA(At, 0, 0); PG8_STAGE(PG8_SA(1, 1), a1 + hstep, voffA);
            PG8_WAIT_V(8); PG8_WAIT_L(0); PG8_BAR; PG8_MMA(0, 0, At, B0); PG8_MMA(0, 1, At, B1); PG8_BAR; PG8_SCHED;
            PG8_LDA(At, 0, 1); PG8_STAGE(PG8_SB(0, 0), b2, voffB); PG8_STAGE(PG8_SB(0, 1), b2 + hstep, voffB); PG8_STAGE(PG8_SA(0, 0), a2, voffA);
            PG8_WAIT_V(8); PG8_WAIT_L(0); PG8_BAR; PG8_MMA(1, 0, At, B0); PG8_MMA(1, 1, At, B1); PG8_BAR; PG8_SCHED;
            PG8_LDB(B0, 1, 0); PG8_LDB(B1, 1, 1); PG8_SCHED; PG8_LDA(At, 1, 0); PG8_STAGE(PG8_SA(0, 1), a2 + hstep, voffA);
            PG8_WAIT_V(8); PG8_WAIT_L(0); PG8_BAR; PG8_MMA(0, 0, At, B0); PG8_MMA(0, 1, At, B1); PG8_BAR; PG8_SCHED;
            PG8_LDA(At, 1, 1); PG8_STAGE(PG8_SB(1, 0), b3, voffB); PG8_STAGE(PG8_SB(1, 1), b3 + hstep, voffB); PG8_STAGE(PG8_SA(1, 0), a3, voffA);
            PG8_WAIT_V(8); PG8_WAIT_L(0); PG8_BAR; PG8_MMA(1, 0, At, B0); PG8_MMA(1, 1, At, B1); PG8_BAR; PG8_SCHED;
            } else {
            PG8_LDB(B0, 0, 0); PG8_SCHED; PG8_LDA(At, 0, 0); PG8_STAGE(PG8_SA(1, 1), a1 + hstep, voffA);
            PG8_WAIT_L(8); PG8_BAR; PG8_WAIT_L(0); PG8_MMA(0, 0, At, B0); PG8_BAR; PG8_SCHED;
            PG8_LDB(B1, 0, 1); PG8_STAGE(PG8_SB(0, 0), b2, voffB);
            PG8_BAR; PG8_WAIT_L(0); PG8_MMA(0, 1, At, B1); PG8_BAR;
            PG8_LDA(At, 0, 1); PG8_STAGE(PG8_SA(0, 0), a2, voffA);
            PG8_BAR; PG8_WAIT_L(0); PG8_MMA(1, 0, At, B0); PG8_BAR; PG8_SCHED;
            PG8_STAGE(PG8_SB(0, 1), b2 + hstep, voffB);
            PG8_WAIT_V(6); PG8_BAR; PG8_MMA(1, 1, At, B1); PG8_BAR;
            PG8_LDB(B0, 1, 0); PG8_SCHED; PG8_LDA(At, 1, 0); PG8_STAGE(PG8_SA(0, 1), a2 + hstep, voffA);
            PG8_WAIT_L(8); PG8_BAR; PG8_WAIT_L(0); PG8_MMA(0, 0, At, B0); PG8_BAR; PG8_SCHED;
            PG8_LDB(B1, 1, 1); PG8_STAGE(PG8_SB(1, 0), b3, voffB);
            PG8_BAR; PG8_WAIT_L(0); PG8_MMA(0, 1, At, B1); PG8_BAR;
            PG8_LDA(At, 1, 1); PG8_STAGE(PG8_SA(1, 0), a3, voffA);
            PG8_BAR; PG8_WAIT_L(0); PG8_MMA(1, 0, At, B0); PG8_BAR; PG8_SCHED;
            PG8_STAGE(PG8_SB(1, 1), b3 + hstep, voffB);
            PG8_WAIT_V(6); PG8_BAR; PG8_MMA(1, 1, At, B1); PG8_BAR;
            }
        }
        if constexpr (ALIGN_EPI) { if (wr == 0) PG8_BAR; }
        if constexpr (!Epi::AFTER_DRAIN) { E(acc, cur, wr, wc, fr, fq); S.done(cur); }
        if (!has_next) break;
        if constexpr (!Epi::KEEP_ACC) {
#pragma unroll
        for (int a = 0; a < 2; ++a)
#pragma unroll
            for (int b = 0; b < 2; ++b)
#pragma unroll
                for (int m = 0; m < 4; ++m)
#pragma unroll
                    for (int n = 0; n < 2; ++n) acc[a][b][m][n] = (f32x4){0.f, 0.f, 0.f, 0.f};
        }
        cur = nxt; cA = nA; cB = nB; ++ui;
        if constexpr (ALIGN_EPI) { if (wr == 1) PG8_BAR; }
    }
    PG8_WAIT_V(0);
    if constexpr (!ALIGN_EPI) { if (wr == 0) PG8_BAR; }
    PG8_BAR;
    if constexpr (Epi::AFTER_DRAIN) { E.fused(acc, cur, wr, wc, fr, fq, lds, wid, lane); S.done(cur); }
#undef PG8_SA
#undef PG8_SB
#undef PG8_STAGE
#undef PG8_LDA
#undef PG8_LDB
#undef PG8_MMA
#undef PG8_WAIT_V
#undef PG8_WAIT_L
#undef PG8_BAR
#undef PG8_SCHED
}
}
#include <hip/hip_bf16.h>
#include <cmath>
namespace attn_body {
using bf16=__hip_bfloat16;
using bf16x8=__attribute__((ext_vector_type(8)))short;
using s16x4=__attribute__((ext_vector_type(4)))short;
using f32x16=__attribute__((ext_vector_type(16)))float;
using u32x4=__attribute__((ext_vector_type(4)))unsigned;
using f32x4b=__attribute__((ext_vector_type(4)))float;
constexpr int BATCH=8,NHEAD=8,SEQ=2048,D=64,DM=NHEAD*D;
constexpr int NW=8,QBLK=32,QB=QBLK*NW,KVBLK=64,NQB=SEQ/QB;
constexpr int ATTN_PITCH=DM, ATTN_UNIT_ROWS=QB;
__device__ __forceinline__ int crow(int r,int hi){return (r&3)+8*(r>>2)+4*hi;}
#define SBAR() __builtin_amdgcn_sched_barrier(0)
__device__ __forceinline__ void cmask(f32x16&p0,f32x16&p1,int jb,int qrel,int hi){
  const float NEG=-INFINITY; int kb=64*jb+4*hi;
  #pragma unroll
  for(int r=0;r<16;++r){int kv=kb+(r&3)+8*(r>>2); if(kv>qrel)p0[r]=NEG; if(kv+32>qrel)p1[r]=NEG;}
}

constexpr int NSLOT=3, SLOTB=8192;
constexpr int LDS_K=0, LDS_V=NSLOT*SLOTB, LDS_WS=2*NSLOT*SLOTB, LDS_OST=LDS_WS+NW*64*4, LDS_BIAS=LDS_OST+NW*4096, LDS_SCAN=LDS_BIAS+SEQ*4, LDS_BYTES=LDS_SCAN+256;
constexpr float C2=0.125f*1.4426950408889634f;
__device__ __forceinline__ void glds16(const void*gsrc,unsigned lds_dst){unsigned keep;
  asm volatile("s_mov_b32 %0, m0\n\ts_mov_b32 m0, %2\n\ts_nop 0\n\tglobal_load_lds_dwordx4 %1, off\n\ts_mov_b32 m0, %0":"=&s"(keep):"v"(gsrc),"s"(lds_dst):"memory");}
__device__ __forceinline__ float max3f(float a,float b,float c){float r;asm("v_max3_f32 %0, %1, %2, %3":"=v"(r):"v"(a),"v"(b),"v"(c));return r;}
__device__ __forceinline__ float max2f(float a,float b){float r;asm("v_max_f32_e32 %0, %1, %2":"=v"(r):"v"(a),"v"(b));return r;}
__device__ __forceinline__ float fadd_s(float a,float b){float r;asm("v_add_f32_e32 %0, %1, %2":"=v"(r):"v"(a),"v"(b));return r;}
__device__ __forceinline__ float fsub_s(float a,float b){float r;asm("v_sub_f32_e32 %0, %1, %2":"=v"(r):"v"(a),"v"(b));return r;}
typedef float f32x2_t __attribute__((ext_vector_type(2))); typedef __bf16 bf16x2_t __attribute__((ext_vector_type(2)));
__device__ __forceinline__ unsigned cvtpk_s(float lo,float hi){f32x2_t v={lo,hi};bf16x2_t b=__builtin_convertvector(v,bf16x2_t);return __builtin_bit_cast(unsigned,b);}
#define WAIT_BAR(N) asm volatile("s_waitcnt vmcnt(" #N ") lgkmcnt(0)\n\ts_barrier":::"memory")

__device__ __forceinline__ void qkt(f32x16&p0,f32x16&p1,const char*Kslot,const bf16x8*qr,int r32,int hi){
  const char*kb=Kslot+hi*1024+r32*16;
  #pragma unroll
  for(int d0=0;d0<4;++d0){
    const bf16x8 b0=*reinterpret_cast<const bf16x8*>(kb+d0*2048);
    const bf16x8 b1=*reinterpret_cast<const bf16x8*>(kb+d0*2048+512);
    {p0=__builtin_amdgcn_mfma_f32_32x32x16_bf16(b0,qr[d0],p0,0,0,0);p1=__builtin_amdgcn_mfma_f32_32x32x16_bf16(b1,qr[d0],p1,0,0,0);}}
}
typedef __attribute__((address_space(3))) const char* lds_cptr;
typedef short v4i16_t __attribute__((ext_vector_type(4)));
__device__ __forceinline__ void kload8(bf16x8*kf,lds_cptr kp){
  kf[0]=*(const __attribute__((address_space(3))) bf16x8*)(kp);      kf[1]=*(const __attribute__((address_space(3))) bf16x8*)(kp+512);
  kf[2]=*(const __attribute__((address_space(3))) bf16x8*)(kp+2048); kf[3]=*(const __attribute__((address_space(3))) bf16x8*)(kp+2560);
  kf[4]=*(const __attribute__((address_space(3))) bf16x8*)(kp+4096); kf[5]=*(const __attribute__((address_space(3))) bf16x8*)(kp+4608);
  kf[6]=*(const __attribute__((address_space(3))) bf16x8*)(kp+6144); kf[7]=*(const __attribute__((address_space(3))) bf16x8*)(kp+6656);
}
__device__ __forceinline__ void kload2(bf16x8*kf,lds_cptr kp,int j){ kf[2*j]=*(const __attribute__((address_space(3))) bf16x8*)(kp+j*2048); kf[2*j+1]=*(const __attribute__((address_space(3))) bf16x8*)(kp+j*2048+512); }
__device__ __forceinline__ s16x4 vtr(lds_cptr p){ return __builtin_bit_cast(s16x4,__builtin_amdgcn_ds_read_tr16_b64_v4i16((__attribute__((address_space(3))) v4i16_t*)p)); }
__device__ __forceinline__ float rowmax(const f32x16&p0,const f32x16&p1){
  float a=max3f(p0[0],p0[1],p1[0]),b=max3f(p0[2],p0[3],p1[1]);a=max3f(a,p1[2],p1[3]);
  #pragma unroll
  for(int r=4;r<16;r+=4){a=max3f(a,p0[r],p0[r+1]);b=max3f(b,p0[r+2],p0[r+3]);a=max3f(a,p1[r],p1[r+1]);b=max3f(b,p1[r+2],p1[r+3]);}
  const float m=max2f(a,b);
  auto rr=__builtin_amdgcn_permlane32_swap(__float_as_uint(m),__float_as_uint(m),false,false);
  return max2f(__uint_as_float(rr[0]),__uint_as_float(rr[1]));
}
__device__ __forceinline__ void pv(f32x16*o,int vb,bf16x8 pa0,bf16x8 pa1,bf16x8 pa2,bf16x8 pa3){
  #pragma unroll
  for(int d0=0;d0<2;++d0){s16x4 lo[4],hi[4];
    #pragma unroll
    for(int ks=0;ks<4;++ks){
      asm volatile("ds_read_b64_tr_b16 %0,%1 offset:%c2":"=&v"(lo[ks]):"v"(vb),"i"(d0*4096+ks*1024):"memory");
      asm volatile("ds_read_b64_tr_b16 %0,%1 offset:%c2":"=&v"(hi[ks]):"v"(vb),"i"(d0*4096+ks*1024+512):"memory");}
    asm volatile("s_waitcnt lgkmcnt(0)":::"memory");SBAR();
    #define PK(k) (bf16x8){lo[k][0],lo[k][1],lo[k][2],lo[k][3],hi[k][0],hi[k][1],hi[k][2],hi[k][3]}
    o[d0]=__builtin_amdgcn_mfma_f32_32x32x16_bf16(pa0,PK(0),o[d0],0,0,0);
    o[d0]=__builtin_amdgcn_mfma_f32_32x32x16_bf16(pa1,PK(1),o[d0],0,0,0);
    o[d0]=__builtin_amdgcn_mfma_f32_32x32x16_bf16(pa2,PK(2),o[d0],0,0,0);
    o[d0]=__builtin_amdgcn_mfma_f32_32x32x16_bf16(pa3,PK(3),o[d0],0,0,0);
    #undef PK
  }
}

#ifndef ATTN_STORE16
#define ATTN_STORE16(p,v) (*(u32x4*)(p)=(v))
#endif
template<int THRL> __device__ __forceinline__ void attn_unit(int b,int h,int qb,const bf16*Q,const bf16*__restrict__ K,const bf16*__restrict__ V,bf16*O,char*shm,const float*fxf,float bfh){
  int tid_o=threadIdx.x; asm volatile("":"+v"(tid_o)); const int tid=tid_o,lane=tid&63,r32=lane&31,hi=lane>>5; const int wid=__builtin_amdgcn_readfirstlane(tid>>6);
  const long rowbase=(long)b*SEQ; const int q0=qb*QB;
  const lds_cptr shm3b=(lds_cptr)shm;

  {
    float* bl=(float*)(shm+LDS_BIAS); float* sc=(float*)(shm+LDS_SCAN);
    const int nkeys=q0+QB; const int s0=4*tid; float c0=0.f,c1=0.f,c2=0.f,c3=0.f;
    if(s0<nkeys){ const float* fp=fxf+((long)(rowbase+s0))*8+h; float z0=fp[0]+bfh,z1=fp[8]+bfh,z2=fp[16]+bfh,z3=fp[24]+bfh;
      c0=fminf(z0,0.f)-log1pf(expf(-fabsf(z0))); c1=c0+(fminf(z1,0.f)-log1pf(expf(-fabsf(z1)))); c2=c1+(fminf(z2,0.f)-log1pf(expf(-fabsf(z2)))); c3=c2+(fminf(z3,0.f)-log1pf(expf(-fabsf(z3)))); }
    float incl=c3;
    #pragma unroll
    for(int o=1;o<64;o<<=1){ const float t_=__shfl_up(incl,o); if(lane>=o)incl+=t_; }
    if(lane==63)sc[wid]=incl;
    __syncthreads();
    float woff=0.f;
    #pragma unroll
    for(int w_=0;w_<NW;++w_){ const float t_=sc[w_]; if(w_<wid)woff+=t_; }
    const float excl=woff+incl-c3; c0+=excl;c1+=excl;c2+=excl;c3+=excl;
    if(s0<nkeys){ bl[s0]=c0; bl[s0+1]=c1; bl[s0+2]=c2; bl[s0+3]=c3; }
    __syncthreads();
    const float cref=bl[q0];
    __syncthreads();
    const float L2E=1.4426950408889634f;
    if(s0<nkeys){ bl[s0]=(cref-c0)*L2E; bl[s0+1]=(cref-c1)*L2E; bl[s0+2]=(cref-c2)*L2E; bl[s0+3]=(cref-c3)*L2E; }
    __syncthreads();
  }
  const __attribute__((address_space(3))) float* bias3=(const __attribute__((address_space(3))) float*)(shm3b+LDS_BIAS)+4*hi;
  #define CINIT(P0,P1,t) do{ const __attribute__((address_space(3))) float* bp_=bias3+64*(t); \
    _Pragma("unroll") for(int g_=0;g_<4;++g_){ const f32x4b b0_=*(const __attribute__((address_space(3))) f32x4b*)(bp_+8*g_); const f32x4b b1_=*(const __attribute__((address_space(3))) f32x4b*)(bp_+32+8*g_); \
      P0[4*g_]=b0_[0]-mhat;P0[4*g_+1]=b0_[1]-mhat;P0[4*g_+2]=b0_[2]-mhat;P0[4*g_+3]=b0_[3]-mhat; P1[4*g_]=b1_[0]-mhat;P1[4*g_+1]=b1_[1]-mhat;P1[4*g_+2]=b1_[2]-mhat;P1[4*g_+3]=b1_[3]-mhat; } }while(0)
  const bf16*Qw=Q+(rowbase+q0+wid*QBLK)*DM+h*D;
  const bf16*Kh=K+rowbase*DM+h*D,*Vh=V+rowbase*DM+h*D;
  const unsigned lds0=(unsigned)(uintptr_t)shm;
  float*wsf=(float*)(shm+LDS_WS)+wid*64;
  const bf16*ksrc=Kh+(long)lane*DM+wid*8;
  const bf16*vsrc=Vh+(long)(16*(wid&3)+(lane>>2))*DM+(wid>>2)*32+(lane&3)*8;
  const unsigned kdst=lds0+LDS_K+wid*1024, vdst=lds0+LDS_V+wid*1024;
  #define DMA_K(t,slot) glds16(ksrc+(long)(t)*KVBLK*DM,(unsigned)__builtin_amdgcn_readfirstlane(kdst+(slot)))
  #define DMA_V(t,slot) glds16(vsrc+(long)(t)*KVBLK*DM,(unsigned)__builtin_amdgcn_readfirstlane(vdst+(slot)))
  const int vb0=(int)(lds0+LDS_V)+((lane>>4)&1)*32+(lane&3)*8+(4*hi+((lane&15)>>2))*64;
  const char*Kbase=shm+LDS_K; bf16x8 kf[8];
  const lds_cptr shm3=(lds_cptr)shm; const lds_cptr kp0=shm3+LDS_K+hi*1024+r32*16; const lds_cptr vp0=shm3+LDS_V+((lane>>4)&1)*32+(lane&3)*8+(4*hi+((lane&15)>>2))*64;
  const int NT=(q0+QB)/KVBLK;
  DMA_K(0,0);DMA_V(0,0);DMA_K(1,SLOTB);
  bf16x8 qr[4];
  #pragma unroll
  for(int d0=0;d0<4;++d0)qr[d0]=*reinterpret_cast<const bf16x8*>(&Qw[(long)r32*DM+d0*16+hi*8]);
  float mhat=((const float*)(shm+LDS_BIAS))[q0+wid*QBLK+r32],l_reg=0.f;f32x16 o[2];o[0]=f32x16{};o[1]=f32x16{};
  const int qrel=wid*QBLK+r32;
  #define CMASK(P0,P1,t) do{int jb_=(t)-(NT-4); if(jb_>=0)cmask(P0,P1,jb_,qrel,hi);}while(0)
  bool resc=false;
  #define START(P0,P1) do{ const float rm=rowmax(P0,P1); resc=false; \
    { const float dl=__builtin_fmaxf(rm,0.f); mhat=fadd_s(mhat,dl); \
      _Pragma("unroll") for(int r=0;r<16;++r){P0[r]=fsub_s(P0[r],dl);P1[r]=fsub_s(P1[r],dl);} \
      } \
    _Pragma("unroll") for(int r=0;r<16;++r)P0[r]=__builtin_amdgcn_exp2f(P0[r]); }while(0)
  #define RESC() do{ if(resc){ asm volatile("s_waitcnt lgkmcnt(0)":::"memory"); \
      _Pragma("unroll") for(int d_=0;d_<2;++d_) _Pragma("unroll") for(int r=0;r<16;++r)o[d_][r]*=wsf[crow(r,hi)]; } }while(0)
  f32x16 pA0,pA1,pB0,pB1;
  int sl_prev=0,sl_cur=0,sl_next=SLOTB;
  #define ROT() do{sl_prev=sl_cur;sl_cur=sl_next;sl_next=(sl_next==(NSLOT-1)*SLOTB)?0:sl_next+SLOTB;}while(0)
  DMA_K(2,2*SLOTB);
  WAIT_BAR(3);
  CINIT(pA0,pA1,0); qkt(pA0,pA1,Kbase,qr,r32,hi);asm volatile("s_nop 15\n\ts_nop 7":"+v"(pA0),"+v"(pA1));CMASK(pA0,pA1,0);
  START(pA0,pA1);
  _Pragma("unroll") for(int r=0;r<16;++r)pA1[r]=__builtin_amdgcn_exp2f(pA1[r]);
  WAIT_BAR(0);
  DMA_K(3,0);DMA_V(1,SLOTB);
  ROT();
  kload8(kf,kp0+sl_cur);
  WAIT_BAR(2);
  s16x4 vlo[8],vhi[8]; u32x4 pw0,pw1,pw2,pw3;
  #define PKW(P,B) cvtpk_s(P[B],P[B+1])
  #define PAF(k) __builtin_bit_cast(bf16x8,pw##k)
  #define VFR(i) (bf16x8){vlo[i][0],vlo[i][1],vlo[i][2],vlo[i][3],vhi[i][0],vhi[i][1],vhi[i][2],vhi[i][3]}
  #define PIN(x) asm volatile("":"+v"(x))
  #define MX3(a,b,c) __builtin_fmaxf(__builtin_fmaxf((a),(b)),(c))
  #define GAPA(MF,A0,A1,A2,A3,W0,W1,PW) do{ MF; sacc+=A0; sacc+=A1; sacc+=A2; sacc+=A3; PIN(sacc); W0; W1; PIN(PW); SBAR(); }while(0)
  #define EX(v) __builtin_amdgcn_exp2f(v)
  #define GAPB(MF,X,B) do{ MF; X[B]=EX(X[B]); X[B+1]=EX(X[B+1]); X[B+2]=EX(X[B+2]); X[B+3]=EX(X[B+3]); PIN(X); SBAR(); }while(0)
  #define VRD(i) do{ vlo[i]=vtr(vp_+(((i)>>2)*4096+((i)&3)*1024)); vhi[i]=vtr(vp_+(((i)>>2)*4096+((i)&3)*1024+512)); }while(0)
  #define KRD(G,j) do{ if(G){ kload2(kf,kp0+sl_next,j); SBAR(); } }while(0)
  #define STEP(C0,C1,P0,P1,t,GK,GV,GL) do{ SBAR(); CINIT(C0,C1,t); SBAR(); \
    const lds_cptr vp_=vp0+sl_prev; \
    VRD(0); SBAR(); float sacc=(P0[0]+P0[1]); \
    GAPA(C0=__builtin_amdgcn_mfma_f32_32x32x16_bf16(kf[0],qr[0],C0,0,0,0), P0[2],P0[3],P0[4],P0[5],     pw0[0]=PKW(P0,0), pw0[1]=PKW(P0,2), pw0); \
    VRD(4); SBAR(); GAPA(C1=__builtin_amdgcn_mfma_f32_32x32x16_bf16(kf[1],qr[0],C1,0,0,0), P0[6],P0[7],P0[8],P0[9],     pw0[2]=PKW(P0,4), pw0[3]=PKW(P0,6), pw0); \
    VRD(1); SBAR(); GAPA(C0=__builtin_amdgcn_mfma_f32_32x32x16_bf16(kf[2],qr[1],C0,0,0,0),   P0[10],P0[11],P0[12],P0[13], pw1[0]=PKW(P0,8), pw1[1]=PKW(P0,10), pw1); \
    VRD(5); SBAR(); GAPA(C1=__builtin_amdgcn_mfma_f32_32x32x16_bf16(kf[3],qr[1],C1,0,0,0),   P0[14],P0[15],P1[0],P1[1],   pw1[2]=PKW(P0,12),pw1[3]=PKW(P0,14), pw1); \
    VRD(2); SBAR(); GAPA(C0=__builtin_amdgcn_mfma_f32_32x32x16_bf16(kf[4],qr[2],C0,0,0,0),   P1[2],P1[3],P1[4],P1[5],     pw2[0]=PKW(P1,0), pw2[1]=PKW(P1,2), pw2); \
    VRD(6); SBAR(); GAPA(C1=__builtin_amdgcn_mfma_f32_32x32x16_bf16(kf[5],qr[2],C1,0,0,0),   P1[6],P1[7],P1[8],P1[9],     pw2[2]=PKW(P1,4), pw2[3]=PKW(P1,6), pw2); \
    VRD(3); SBAR(); GAPA(C0=__builtin_amdgcn_mfma_f32_32x32x16_bf16(kf[6],qr[3],C0,0,0,0),   P1[10],P1[11],P1[12],P1[13], pw3[0]=PKW(P1,8), pw3[1]=PKW(P1,10), pw3); \
    VRD(7); SBAR(); GAPA(C1=__builtin_amdgcn_mfma_f32_32x32x16_bf16(kf[7],qr[3],C1,0,0,0),   P1[14],P1[15],0.f,0.f,       pw3[2]=PKW(P1,12),pw3[3]=PKW(P1,14), pw3); \
    l_reg+=sacc; \
    if(GK){DMA_K((t)+3,sl_cur);} if(GV){DMA_V((t)+1,sl_next);} \
    CMASK(C0,C1,t); \
    { float a=MX3(C0[0],C0[1],C1[0]),b=MX3(C0[2],C0[3],C1[1]); a=MX3(a,C1[2],C1[3]); \
      _Pragma("unroll") for(int r=4;r<16;r+=4){a=MX3(a,C0[r],C0[r+1]);b=MX3(b,C0[r+2],C0[r+3]);a=MX3(a,C1[r],C1[r+1]);b=MX3(b,C1[r+2],C1[r+3]);} \
      float rm=__builtin_fmaxf(a,b); { auto rr=__builtin_amdgcn_permlane32_swap(__float_as_uint(rm),__float_as_uint(rm),false,false); rm=__builtin_fmaxf(__uint_as_float(rr[0]),__uint_as_float(rr[1])); } \
      resc=false; \
      if(__builtin_expect(__any(rm>(float)THRL),0)){ const float dl=__builtin_fmaxf(rm,0.f); mhat+=dl; \
        _Pragma("unroll") for(int r=0;r<16;++r){C0[r]-=dl;C1[r]-=dl;} \
        const float f=__builtin_amdgcn_exp2f(-dl); l_reg*=f; if(hi==0)wsf[r32]=f; resc=true; } } \
    SBAR(); \
    GAPB(o[0]=__builtin_amdgcn_mfma_f32_32x32x16_bf16(PAF(0),VFR(0),o[0],0,0,0), C0,0); \
    GAPB(o[1]=__builtin_amdgcn_mfma_f32_32x32x16_bf16(PAF(0),VFR(4),o[1],0,0,0), C0,4); \
    KRD(GL,0); GAPB(o[0]=__builtin_amdgcn_mfma_f32_32x32x16_bf16(PAF(1),VFR(1),o[0],0,0,0), C0,8); \
    KRD(GL,1); GAPB(o[1]=__builtin_amdgcn_mfma_f32_32x32x16_bf16(PAF(1),VFR(5),o[1],0,0,0), C0,12); \
    KRD(GL,2); GAPB(o[0]=__builtin_amdgcn_mfma_f32_32x32x16_bf16(PAF(2),VFR(2),o[0],0,0,0), C1,0); \
    KRD(GL,3); GAPB(o[1]=__builtin_amdgcn_mfma_f32_32x32x16_bf16(PAF(2),VFR(6),o[1],0,0,0), C1,4); \
    GAPB(o[0]=__builtin_amdgcn_mfma_f32_32x32x16_bf16(PAF(3),VFR(3),o[0],0,0,0), C1,8); \
    GAPB(o[1]=__builtin_amdgcn_mfma_f32_32x32x16_bf16(PAF(3),VFR(7),o[1],0,0,0), C1,12); \
    }while(0)
  int t=1;
  #undef CMASK
  #define CMASK(P0,P1,t) do{}while(0)
  for(;t+5<NT;t+=2){
    STEP(pB0,pB1,pA0,pA1,t,true,true,true);     WAIT_BAR(2); RESC(); ROT();
    STEP(pA0,pA1,pB0,pB1,t+1,true,true,true);   WAIT_BAR(2); RESC(); ROT();
  }
  #undef CMASK
  #define CMASK(P0,P1,t) do{int jb_=(t)-(NT-4); if(jb_>=0)cmask(P0,P1,jb_,qrel,hi);}while(0)
  #define ENDW(tt) do{ if((tt)+3<NT){WAIT_BAR(2);} else if((tt)+2<NT){WAIT_BAR(1);} else {WAIT_BAR(0);} }while(0)
  for(;t+1<NT;t+=2){
    STEP(pB0,pB1,pA0,pA1,t,(t+3<NT),(t+1<NT),(t+1<NT));       ENDW(t);   RESC(); ROT();
    STEP(pA0,pA1,pB0,pB1,t+1,(t+4<NT),(t+2<NT),(t+2<NT));     ENDW(t+1); RESC(); ROT();
  }
  STEP(pB0,pB1,pA0,pA1,NT-1,false,false,false); RESC();
  { float sacc=pB0[0]+pB0[1]; _Pragma("unroll") for(int r=2;r<16;++r)sacc+=pB0[r]; _Pragma("unroll") for(int r=0;r<16;++r)sacc+=pB1[r]; l_reg+=sacc;
    pw0=(u32x4){PKW(pB0,0),PKW(pB0,2),PKW(pB0,4),PKW(pB0,6)};pw1=(u32x4){PKW(pB0,8),PKW(pB0,10),PKW(pB0,12),PKW(pB0,14)};pw2=(u32x4){PKW(pB1,0),PKW(pB1,2),PKW(pB1,4),PKW(pB1,6)};pw3=(u32x4){PKW(pB1,8),PKW(pB1,10),PKW(pB1,12),PKW(pB1,14)};
    SBAR(); pv(o,vb0+sl_cur,PAF(0),PAF(1),PAF(2),PAF(3)); }
  #undef PKW
  #undef PAF
  #undef VFR
  #undef PIN
  #undef MX3
  #undef GAPA
  #undef GAPB
  #undef EX
  #undef VRD
  #undef KRD
  #undef STEP
  #undef ENDW
  {auto rr=__builtin_amdgcn_permlane32_swap(__float_as_uint(l_reg),__float_as_uint(l_reg),false,false);l_reg=__uint_as_float(rr[0])+__uint_as_float(rr[1]);}
  if(hi==0)wsf[32+r32]=l_reg;asm volatile("s_waitcnt lgkmcnt(0)":::"memory");
  float rli[16];
  #pragma unroll
  for(int r=0;r<16;++r)rli[r]=__builtin_amdgcn_rcpf(wsf[32+crow(r,hi)]);
  bf16*Ow=O+(rowbase+q0+wid*QBLK)*DM+h*D;
  { bf16*stg=(bf16*)(shm+LDS_OST)+wid*2048;
    #pragma unroll
    for(int r=0;r<16;++r){const int orow=crow(r,hi);
      #pragma unroll
      for(int d0=0;d0<2;++d0)stg[orow*64+d0*32+r32]=__float2bfloat16(o[d0][r]*rli[r]);}
    asm volatile("s_waitcnt lgkmcnt(0)":::"memory");
    #pragma unroll
    for(int i=0;i<4;++i){const int row=i*8+(lane>>3),ch=lane&7; const u32x4 v=*(const u32x4*)(stg+row*64+ch*8); ATTN_STORE16(Ow+(long)row*DM+ch*8,v);} }
  asm volatile("s_waitcnt lgkmcnt(0)\n\ts_barrier":::"memory");
  #undef CINIT
  #undef DMA_K
  #undef DMA_V
  #undef CMASK
  #undef START
  #undef RESC
  #undef ROT
}
constexpr int ATTN_LDS_BYTES=LDS_BYTES;
struct AttnTensors { const bf16* Q; const bf16* K; const bf16* V; bf16* O; const float* fxf; const float* bf; };
struct AttnUnit { int bh; int qb; };
struct StaticOrder {
  int vcu;
  __device__ __forceinline__ explicit StaticOrder(int grid,int block):vcu((grid%8==0)?((block%8)*(grid/8)+block/8):block){}
  __device__ __forceinline__ bool next(int i,AttnUnit&u)const{ const int idx=vcu+ (i>>1)*0; if(i>=2||idx>=256)return false; const int s=idx&3; u.bh=idx>>2; u.qb=(i==0)?s:7-s; return true; }
  __device__ __forceinline__ void a_ready(const AttnUnit&)const{}
  __device__ __forceinline__ void done(const AttnUnit&)const{}
};
template<class Sched,int THRL=8> __device__ __forceinline__ void attn_phase(char*lds,const AttnTensors&T,const Sched&S){
  AttnUnit u;
  for(int i=0;S.next(i,u);++i){ S.a_ready(u); attn_unit<THRL>(u.bh/NHEAD,u.bh%NHEAD,u.qb,T.Q,T.K,T.V,T.O,lds,T.fxf,T.bf[u.bh%NHEAD]); S.done(u); }
}
#undef SBAR
#undef WAIT_BAR
}

constexpr int M = 16384, DMOD = 1024, SEQL = 2048, FFN_H = 2816, INTOT = 7176;
constexpr size_t MiB = 1u << 20;
constexpr size_t WS_HB = 0, WS_HBL = 32 * MiB, WS_YA = 64 * MiB, WS_YB = 80 * MiB, WS_YC = 96 * MiB;
constexpr size_t WS_FK = WS_YA, WS_FQ = WS_YB, WS_FV = WS_YC;
constexpr size_t WS_ZQ = 112 * MiB, WS_ZF = 128 * MiB, WS_ZI = 160 * MiB, WS_ZG = 176 * MiB, WS_SU = 192 * MiB, WS_KV = 208 * MiB, WS_SE = 240 * MiB, WS_MISC = 248 * MiB;
constexpr size_t WS_GATES = 112 * MiB, WS_MERGED = 208 * MiB, WS_PRE = 112 * MiB, WS_H1B = 176 * MiB, WS_FFH = 0;
constexpr size_t MISC_FXF = 0, MISC_DEC = 1 * MiB, MISC_LB = 2 * MiB;
constexpr size_t DO_WIN = 0, DO_WGLU = 14 * MiB, DO_WBR = 14 * MiB + MiB / 2, DO_WOUT = 17 * MiB + MiB / 2, DO_WGU = 19 * MiB + MiB / 2, DO_WDN = 30 * MiB + MiB / 2,
                 DO_TM = 36 * MiB, DO_EM = 42 * MiB, DO_LAM = 44 * MiB, DO_YG = 48 * MiB;
constexpr int LDS_BYTES = 147456;
constexpr float DN_ALPHA = 1.4142135623730951f, LN_EPS = 1e-5f, RMS_EPS = 1e-6f;

typedef unsigned short u16;
typedef unsigned v4u __attribute__((ext_vector_type(4)));
typedef unsigned v2u __attribute__((ext_vector_type(2)));
typedef float f32x4 __attribute__((ext_vector_type(4)));
typedef short bf16x8 __attribute__((ext_vector_type(8)));
__device__ __forceinline__ unsigned f2bf(float f) { unsigned u = __builtin_bit_cast(unsigned, f); return (u + 0x7fffu + ((u >> 16) & 1u)) >> 16; }
__device__ __forceinline__ unsigned pk2(float lo, float hi) { return f2bf(lo) | (f2bf(hi) << 16); }
__device__ __forceinline__ float bf2f(unsigned h) { return __builtin_bit_cast(float, h << 16); }
__device__ __forceinline__ float bflo(unsigned w) { return __builtin_bit_cast(float, w << 16); }
__device__ __forceinline__ float bfhi(unsigned w) { return __builtin_bit_cast(float, w & 0xffff0000u); }
__device__ __forceinline__ float sigm(float x) { return 1.f / (1.f + __expf(-x)); }
__device__ __forceinline__ float wave_sum(float v) {
#pragma unroll
    for (int o = 1; o < 64; o <<= 1) v += __shfl_xor(v, o);
    return v;
}

struct Args { const float* in[25]; float* out; unsigned char* ws; };

namespace pg8 {
struct EpiIn {
    static constexpr bool PERM = true, AFTER_DRAIN = false, KEEP_ACC = false;
    unsigned char* ws; const float* lb; float c2;
    __device__ __forceinline__ void operator()(f32x4 (&acc)[2][2][4][2], const Unit& u, int wr, int wc, int fr, int fq) const {
        const int seg = u.pn >> 1;
        const int cbase = (u.pn & 1) * 256 + wc * 32 + 8 * fq;
        const int row0 = (u.pm * BM) + wr * 64 + fr;
#pragma unroll
        for (int ai = 0; ai < 2; ++ai)
#pragma unroll
            for (int m = 0; m < 4; ++m) {
                const int row = row0 + ai * HALF + m * 16;
#pragma unroll
                for (int bj = 0; bj < 2; ++bj) {
                    const int c = cbase + bj * HALF;
                    f32x4 v0 = acc[ai][bj][m][0], v1 = acc[ai][bj][m][1];
                    if (seg == 1) {
                        const f32x4 l0 = *(const f32x4*)(lb + c), l1 = *(const f32x4*)(lb + c + 4);
#pragma unroll
                        for (int e = 0; e < 4; ++e) { v0[e] = __logf(l0[e] + (1.f - l0[e]) * sigm(v0[e])); v1[e] = __logf(l1[e] + (1.f - l1[e]) * sigm(v1[e])); }
                        float* p = (float*)(ws + WS_ZF) + (size_t)row * 512 + c;
                        *(f32x4*)p = v0; *(f32x4*)(p + 4) = v1;
                    } else {
                        if (seg == 4) { v0 = v0 * c2; v1 = v1 * c2; }
                        u32x4 w; w.x = cvt_pk_bf16(v0[0], v0[1]); w.y = cvt_pk_bf16(v0[2], v0[3]); w.z = cvt_pk_bf16(v1[0], v1[1]); w.w = cvt_pk_bf16(v1[2], v1[3]);
                        size_t off;
                        if (seg == 7) off = WS_SU + 2 * (((size_t)((c >> 4) * 1024 + (row >> 4))) * 256 + (size_t)((row & 15) * 16 + (c & 15)));
                        else {
                            const size_t base = seg == 0 ? WS_ZQ : seg == 2 ? WS_ZI : seg == 3 ? WS_ZG : seg == 4 ? WS_FQ : seg == 5 ? WS_FK : WS_FV;
                            off = base + 2 * ((size_t)row * 512 + c);
                        }
                        *(u32x4*)(ws + off) = w;
                    }
                }
            }
    }
};
struct EpiGate {
    static constexpr bool PERM = true, AFTER_DRAIN = false, KEEP_ACC = false;
    bf16_t* G;
    __device__ __forceinline__ void operator()(f32x4 (&acc)[2][2][4][2], const Unit& u, int wr, int wc, int fr, int fq) const {
        const int col0 = u.pn * BM + wc * 32 + 8 * fq, row0 = u.pm * BM + wr * 64 + fr;
#pragma unroll
        for (int ai = 0; ai < 2; ++ai)
#pragma unroll
            for (int m = 0; m < 4; ++m) { bf16_t* rowp = G + (size_t)(row0 + ai * HALF + m * 16) * 3072 + col0;
#pragma unroll
                for (int bj = 0; bj < 2; ++bj) { const f32x4 v0 = acc[ai][bj][m][0], v1 = acc[ai][bj][m][1];
                    u32x4 w; w.x = cvt_pk_bf16(sigm(v0[0]), sigm(v0[1])); w.y = cvt_pk_bf16(sigm(v0[2]), sigm(v0[3])); w.z = cvt_pk_bf16(sigm(v1[0]), sigm(v1[1])); w.w = cvt_pk_bf16(sigm(v1[2]), sigm(v1[3]));
                    *(u32x4*)(rowp + bj * HALF) = w; } }
    }
};
struct EpiGlu {
    static constexpr bool PERM = true, AFTER_DRAIN = false, KEEP_ACC = false;
    const bf16_t* Y; bf16_t* O;
    __device__ __forceinline__ void operator()(f32x4 (&acc)[2][2][4][2], const Unit& u, int wr, int wc, int fr, int fq) const {
        const int col0 = u.pn * BM + wc * 32 + 8 * fq, row0 = u.pm * BM + wr * 64 + fr;
#pragma unroll
        for (int ai = 0; ai < 2; ++ai)
#pragma unroll
            for (int m = 0; m < 4; ++m) { const size_t ro = (size_t)(row0 + ai * HALF + m * 16) * 512 + col0;
#pragma unroll
                for (int bj = 0; bj < 2; ++bj) { const f32x4 v0 = acc[ai][bj][m][0], v1 = acc[ai][bj][m][1];
                    const u32x4 y = *(const u32x4*)(Y + ro + bj * HALF);
                    u32x4 w; w.x = cvt_pk_bf16(bflo(y.x) * sigm(v0[0]), bfhi(y.x) * sigm(v0[1])); w.y = cvt_pk_bf16(bflo(y.y) * sigm(v0[2]), bfhi(y.y) * sigm(v0[3]));
                    w.z = cvt_pk_bf16(bflo(y.z) * sigm(v1[0]), bfhi(y.z) * sigm(v1[1])); w.w = cvt_pk_bf16(bflo(y.w) * sigm(v1[2]), bfhi(y.w) * sigm(v1[3]));
                    *(u32x4*)(O + ro + bj * HALF) = w; } }
    }
};
struct EpiBranch {
    static constexpr bool PERM = true, AFTER_DRAIN = false, KEEP_ACC = true;
    const bf16_t* G; bf16_t* O;
    __device__ __forceinline__ void operator()(f32x4 (&acc)[2][2][4][2], const Unit& u, int wr, int wc, int fr, int fq) const {
        const int br = u.pm >> 6, tm = u.pm & 63, tn = u.pn & 3;
        const int col0 = tn * BM + wc * 32 + 8 * fq, row0 = tm * BM + wr * 64 + fr;
#pragma unroll
        for (int ai = 0; ai < 2; ++ai)
#pragma unroll
            for (int m = 0; m < 4; ++m) { const size_t row = (size_t)(row0 + ai * HALF + m * 16);
#pragma unroll
                for (int bj = 0; bj < 2; ++bj) { f32x4 v0 = acc[ai][bj][m][0], v1 = acc[ai][bj][m][1];
                    const bf16_t* gp = G + row * 3072 + col0 + bj * HALF;
                    if (br < 2) {
                        const u32x4 ga = *(const u32x4*)(gp + br * 1024), gb = *(const u32x4*)(gp + (br + 1) * 1024);
                        v0[0] *= bflo(ga.x) * __builtin_amdgcn_rcpf(bflo(gb.x)); v0[1] *= bfhi(ga.x) * __builtin_amdgcn_rcpf(bfhi(gb.x));
                        v0[2] *= bflo(ga.y) * __builtin_amdgcn_rcpf(bflo(gb.y)); v0[3] *= bfhi(ga.y) * __builtin_amdgcn_rcpf(bfhi(gb.y));
                        v1[0] *= bflo(ga.z) * __builtin_amdgcn_rcpf(bflo(gb.z)); v1[1] *= bfhi(ga.z) * __builtin_amdgcn_rcpf(bfhi(gb.z));
                        v1[2] *= bflo(ga.w) * __builtin_amdgcn_rcpf(bflo(gb.w)); v1[3] *= bfhi(ga.w) * __builtin_amdgcn_rcpf(bfhi(gb.w));
                        acc[ai][bj][m][0] = v0; acc[ai][bj][m][1] = v1;
                    } else {
                        const u32x4 ga = *(const u32x4*)(gp + 2048);
                        u32x4 w; w.x = cvt_pk_bf16(v0[0] * bflo(ga.x), v0[1] * bfhi(ga.x)); w.y = cvt_pk_bf16(v0[2] * bflo(ga.y), v0[3] * bfhi(ga.y));
                        w.z = cvt_pk_bf16(v1[0] * bflo(ga.z), v1[1] * bfhi(ga.z)); w.w = cvt_pk_bf16(v1[2] * bflo(ga.w), v1[3] * bfhi(ga.w));
                        *(u32x4*)(O + row * 1024 + col0 + bj * HALF) = w;
                        acc[ai][bj][m][0] = (f32x4){0.f, 0.f, 0.f, 0.f}; acc[ai][bj][m][1] = (f32x4){0.f, 0.f, 0.f, 0.f};
                    } } }
    }
};
struct BranchOrder {
    StaticOrder so;
    __host__ __device__ void init(int G_, int c_) { so.init(16384, 1024, G_, c_); }
    __host__ __device__ bool next(int i, Unit& u) const { const int r = i / 3, br = i - 3 * r; Unit t; if (!so.next(r, t)) return false; u.pm = t.pm + 64 * br; u.pn = t.pn + 4 * br; return true; }
    __device__ __forceinline__ void a_ready(const Unit&) const {}
    __device__ __forceinline__ void done(const Unit&) const {}
};
struct EpiRes {
    static constexpr bool PERM = false, AFTER_DRAIN = false, KEEP_ACC = false;
    const float* resf; const bf16_t* rhi; const bf16_t* rlo; float* out;
    __device__ __forceinline__ void operator()(f32x4 (&acc)[2][2][4][2], const Unit& u, int wr, int wc, int fr, int fq) const {
        const int col0 = u.pn * BM + wc * 32 + 4 * fq, row0 = u.pm * BM + wr * 64 + fr;
#pragma unroll
        for (int ai = 0; ai < 2; ++ai)
#pragma unroll
            for (int m = 0; m < 4; ++m) { const size_t ro = (size_t)(row0 + ai * HALF + m * 16) * 1024 + col0;
#pragma unroll
                for (int bj = 0; bj < 2; ++bj)
#pragma unroll
                    for (int n = 0; n < 2; ++n) { const size_t o = ro + bj * HALF + n * 16; f32x4 r;
                        if (resf) r = *(const f32x4*)(resf + o);
                        else { const v2u h = *(const v2u*)(rhi + o), l = *(const v2u*)(rlo + o); r[0] = bflo(h.x) + bflo(l.x); r[1] = bfhi(h.x) + bfhi(l.x); r[2] = bflo(h.y) + bflo(l.y); r[3] = bfhi(h.y) + bfhi(l.y); }
                        *(f32x4*)(out + o) = r * 1.4142135623730951f + acc[ai][bj][m][n]; } }
    }
};
struct EpiSwiglu {
    static constexpr bool PERM = true, AFTER_DRAIN = false, KEEP_ACC = false;
    bf16_t* O;
    __device__ __forceinline__ void operator()(f32x4 (&acc)[2][2][4][2], const Unit& u, int wr, int wc, int fr, int fq) const {
        const int col0 = u.pn * 128 + wc * 32 + 8 * fq, row0 = u.pm * BM + wr * 64 + fr;
#pragma unroll
        for (int ai = 0; ai < 2; ++ai)
#pragma unroll
            for (int m = 0; m < 4; ++m) { const f32x4 g0 = acc[ai][0][m][0], g1 = acc[ai][0][m][1], u0 = acc[ai][1][m][0], u1 = acc[ai][1][m][1];
                u32x4 w; w.x = cvt_pk_bf16(g0[0] * sigm(g0[0]) * u0[0], g0[1] * sigm(g0[1]) * u0[1]); w.y = cvt_pk_bf16(g0[2] * sigm(g0[2]) * u0[2], g0[3] * sigm(g0[3]) * u0[3]);
                w.z = cvt_pk_bf16(g1[0] * sigm(g1[0]) * u1[0], g1[1] * sigm(g1[1]) * u1[1]); w.w = cvt_pk_bf16(g1[2] * sigm(g1[2]) * u1[2], g1[3] * sigm(g1[3]) * u1[3]);
                *(u32x4*)(O + (size_t)(row0 + ai * HALF + m * 16) * 2816 + col0) = w; }
    }
};
}
#define GAS __attribute__((address_space(1)))
#define LAS __attribute__((address_space(3)))
typedef unsigned short bf16;
typedef unsigned v4u __attribute__((ext_vector_type(4)));
typedef float f32x4 __attribute__((ext_vector_type(4)));
typedef short bf16x8 __attribute__((ext_vector_type(8)));
typedef GAS unsigned gu32;
typedef GAS unsigned long long gu64;
#define RLX_AGENT __ATOMIC_RELAXED, __HIP_MEMORY_SCOPE_AGENT
#define LDS_WAIT() asm volatile("s_waitcnt lgkmcnt(0)" ::: "memory")
#define VM_WAIT() asm volatile("s_waitcnt vmcnt(0)" ::: "memory")
__device__ __forceinline__ unsigned long long rt() { return __builtin_amdgcn_s_memrealtime(); }
#define XB_TMO      128
#define XB_XCNT(j)  (256  + 64 * (j))
#define XB_XSUB(j)  (1280 + 64 * (j))
#define XB_XGEN(j)  (2304 + 64 * (j))
#define XB_TOP      3328
#define XB_TOPGEN   3392
#define XCD_BAR_WORDS 3456
#define XB_SPIN_CAP (1u << 18)

__device__ __forceinline__ unsigned xb_ld(unsigned* p)              { return __hip_atomic_load(p, __ATOMIC_RELAXED, __HIP_MEMORY_SCOPE_AGENT); }
__device__ __forceinline__ unsigned xb_add(unsigned* p, unsigned v) { return __hip_atomic_fetch_add(p, v, __ATOMIC_RELAXED, __HIP_MEMORY_SCOPE_AGENT); }
__device__ __forceinline__ unsigned xb_xcc_id() { return (unsigned)__builtin_amdgcn_s_getreg((3 << 11) | 20) & 0xFu; }
#define XB_SPIN(cond, bar) do { unsigned _sp = 0; while (cond) { __builtin_amdgcn_s_sleep(1); \
    if ((++_sp & 255u) == 0u) { if (xb_ld(&(bar)[XB_TMO])) break; if (_sp > XB_SPIN_CAP) { atomicAdd(&(bar)[XB_TMO], 1u); break; } } } } while (0)

struct XcdBarrier {
    unsigned* bar; unsigned x;
    volatile LAS unsigned* st;
};

__device__ __forceinline__ XcdBarrier xcd_barrier_post(unsigned* bar, volatile LAS unsigned* st) {
    XcdBarrier b; b.bar = bar; b.x = xb_xcc_id(); b.st = st;
    if (threadIdx.x == 0) (void)xb_add(&bar[XB_XCNT(b.x)], 1u);
    return b;
}
__device__ __forceinline__ void xcd_barrier_complete(unsigned* bar, unsigned x, unsigned& nloc, unsigned& nx) {
    const unsigned G = gridDim.x * gridDim.y * gridDim.z;
    unsigned sum, cnt, mine, sp = 0u;
    for (;;) {
        sum = 0u; cnt = 0u; mine = 0u;
#pragma unroll
        for (unsigned j = 0; j < 16; ++j) { const unsigned c = xb_ld(&bar[XB_XCNT(j)]); sum += c; cnt += (c > 0u) ? 1u : 0u; mine = (j == x) ? c : mine; }
        if (sum == G) break;
        __builtin_amdgcn_s_sleep(1);
        if ((++sp & 255u) == 0u) { if (xb_ld(&bar[XB_TMO])) break; if (sp > XB_SPIN_CAP) { atomicAdd(&bar[XB_TMO], 1u); break; } }
    }
    nloc = mine > 0u ? mine : 1u; nx = cnt > 0u ? cnt : 1u;
}

__device__ __forceinline__ void xcd_barrier(const XcdBarrier& b) {
    asm volatile("s_waitcnt vmcnt(0)" ::: "memory");
    __syncthreads();
    if (threadIdx.x == 0) {
        unsigned* bar = b.bar;
        __builtin_amdgcn_s_waitcnt(0);
        unsigned nloc = b.st[0], nx = b.st[1];
        if (nloc == 0u) { xcd_barrier_complete(bar, b.x, nloc, nx); b.st[0] = nloc; b.st[1] = nx; }
        const unsigned old = xb_add(&bar[XB_XSUB(b.x)], 1u);
        const unsigned gen = old / nloc;
        if (old + 1u == (gen + 1u) * nloc) {
            __builtin_amdgcn_fence(__ATOMIC_RELEASE, "agent");
            asm volatile("s_waitcnt vmcnt(0)" ::: "memory");
            const unsigned og = xb_add(&bar[XB_TOP], 1u);
            const unsigned tg = og / nx;
            if (og + 1u == (tg + 1u) * nx) xb_add(&bar[XB_TOPGEN], 1u);
            else XB_SPIN(xb_ld(&bar[XB_TOPGEN]) == tg, bar);
            __builtin_amdgcn_fence(__ATOMIC_ACQUIRE, "agent");
            xb_add(&bar[XB_XGEN(b.x)], 1u);
            asm volatile("s_waitcnt vmcnt(0)" ::: "memory");
        } else {
            XB_SPIN(xb_ld(&bar[XB_XGEN(b.x)]) == gen, bar);
            __builtin_amdgcn_fence(__ATOMIC_ACQUIRE, "agent");
            asm volatile("s_waitcnt vmcnt(0)" ::: "memory");
        }
    }
    __syncthreads();
}

struct Frame { unsigned char* lds; unsigned char* ws; unsigned char* dout; int G, vcu; };
__device__ __forceinline__ int opq_tid() { int t = threadIdx.x; asm volatile("" : "+v"(t)); return t; }
#define F_TID (opq_tid())
#define F_LANE (opq_tid() & 63)
#define F_WAVE (__builtin_amdgcn_readfirstlane(opq_tid() >> 6))

__device__ __forceinline__ void cvt_item(const float* src, int ld, int K, int ncb, u16* dst, int grp, int stride, int base, int item, float* scr, int lane) {
    const int kb = item / ncb, nb = item - kb * ncb, k0 = 64 * kb, n0 = 32 * nb;
#pragma unroll
    for (int i = 0; i < 32; ++i) { const int kk = 2 * i + (lane >> 5); scr[kk * 33 + (lane & 31)] = src[(size_t)(k0 + kk) * ld + n0 + (lane & 31)]; }
    asm volatile("s_waitcnt lgkmcnt(0)" ::: "memory");
    const int c = lane & 7;
    const int drow0 = base + (n0 / grp) * stride + (n0 % grp);
#pragma unroll
    for (int j = 0; j < 4; ++j) { const int n = (lane >> 3) + 8 * j; const float* s = scr + (8 * c) * 33 + n;
        v4u o; o.x = pk2(s[0 * 33], s[1 * 33]); o.y = pk2(s[2 * 33], s[3 * 33]); o.z = pk2(s[4 * 33], s[5 * 33]); o.w = pk2(s[6 * 33], s[7 * 33]);
        *(v4u*)(dst + (size_t)(drow0 + n) * K + k0 + 8 * c) = o; }
    asm volatile("s_waitcnt lgkmcnt(0)" ::: "memory");
}
__device__ __forceinline__ void convert_weights(const Frame& F, const Args& a, int l) {
    float* scr = (float*)(F.lds + F_WAVE * 16384);
    const int gw = F.vcu * 8 + F_WAVE, NGW = F.G * 8;
    const float* win = a.in[1] + (size_t)l * DMOD * INTOT;
    unsigned char* d = F.dout;
    constexpr int BIG = 1 << 30;
    constexpr int I0 = 16 * 112, I1 = 16 * 16, I2 = 16 * 96, I3 = 8 * 16, I4 = 8 * 32, I7 = 16 * 32, I8 = 16 * 88, I10 = 44 * 32;
    constexpr int NIT = I0 + I1 + I2 + I3 + 3 * I4 + I7 + 2 * I8 + I10;
    for (int it = gw; it < NIT; it += NGW) {
        int r = it;
        if (r < I0) { cvt_item(win, INTOT, 1024, 112, (u16*)(d + DO_WIN), BIG, 0, 0, r, scr, F_LANE); continue; } r -= I0;
        if (r < I1) { cvt_item(win + 3592, INTOT, 1024, 16, (u16*)(d + DO_WIN), BIG, 0, 3584, r, scr, F_LANE); continue; } r -= I1;
        if (r < I2) { cvt_item(win + 4104, INTOT, 1024, 96, (u16*)(d + DO_WIN), BIG, 0, 4096, r, scr, F_LANE); continue; } r -= I2;
        if (r < I3) { cvt_item(a.in[13] + (size_t)l * 512 * 512, 512, 512, 16, (u16*)(d + DO_WGLU), BIG, 0, 0, r, scr, F_LANE); continue; } r -= I3;
        if (r < I4) { cvt_item(a.in[14] + (size_t)l * 512 * 1024, 1024, 512, 32, (u16*)(d + DO_WBR), BIG, 0, 0, r, scr, F_LANE); continue; } r -= I4;
        if (r < I4) { cvt_item(a.in[15] + (size_t)l * 512 * 1024, 1024, 512, 32, (u16*)(d + DO_WBR), BIG, 0, 1024, r, scr, F_LANE); continue; } r -= I4;
        if (r < I4) { cvt_item(a.in[16] + (size_t)l * 512 * 1024, 1024, 512, 32, (u16*)(d + DO_WBR), BIG, 0, 2048, r, scr, F_LANE); continue; } r -= I4;
        if (r < I7) { cvt_item(a.in[17] + (size_t)l * 1024 * 1024, 1024, 1024, 32, (u16*)(d + DO_WOUT), BIG, 0, 0, r, scr, F_LANE); continue; } r -= I7;
        if (r < I8) { cvt_item(a.in[20] + (size_t)l * 1024 * FFN_H, FFN_H, 1024, 88, (u16*)(d + DO_WGU), 128, 256, 0, r, scr, F_LANE); continue; } r -= I8;
        if (r < I8) { cvt_item(a.in[21] + (size_t)l * 1024 * FFN_H, FFN_H, 1024, 88, (u16*)(d + DO_WGU), 128, 256, 128, r, scr, F_LANE); continue; } r -= I8;
        cvt_item(a.in[22] + (size_t)l * FFN_H * 1024, 1024, FFN_H, 32, (u16*)(d + DO_WDN), BIG, 0, 0, r, scr, F_LANE);
    }
}

__device__ __forceinline__ void s5_mats(const Frame& F, const Args& a, int l) {
    float2* LP = (float2*)(F.lds);
    float2* BB = (float2*)(F.lds + 16384);
    float2* CC = (float2*)(F.lds + 32768);
    float* KT = (float*)(F.lds + 49152);
    u16* TM = (u16*)(F.dout + DO_TM); u16* EM = (u16*)(F.dout + DO_EM); float2* LAM = (float2*)(F.dout + DO_LAM);
    const int tid = F_TID;
    for (int unit = blockIdx.x; unit < 256; unit += F.G) {
        const int g = unit >> 3, part = unit & 7;
        __syncthreads();
        const float dt = __expf(a.in[7][l * 32 + g]);
        const float* lre = a.in[5] + (size_t)(l * 32 + g) * 64; const float* lim = a.in[6] + (size_t)(l * 32 + g) * 64;
        for (int e = tid; e < 17 * 64; e += 512) { const int tau = e >> 6, p = e & 63; const float mg = expf(lre[p] * dt * (float)tau); float sn, cs; sincosf(lim[p] * dt * (float)tau, &sn, &cs); LP[e] = make_float2(mg * cs, mg * sn); }
        for (int e = tid; e < 1024; e += 512) { const int p = e >> 4;
            const float lr = lre[p], li = lim[p]; const float mg = expf(lr * dt); float sn, cs; sincosf(li * dt, &sn, &cs);
            const float nr = mg * cs - 1.f, ni = mg * sn, den = 1.f / (lr * lr + li * li);
            const float qr = (nr * lr + ni * li) * den, qi = (ni * lr - nr * li) * den;
            const size_t bi = ((size_t)(l * 32 + g) * 64 + p) * 16 + (e & 15);
            const float br = a.in[8][bi], bim = a.in[9][bi];
            BB[e] = make_float2(qr * br - qi * bim, qr * bim + qi * br);
            const size_t ci = (size_t)(l * 32 + g) * 1024 + e;
            CC[e] = make_float2(a.in[10][ci], a.in[11][ci]); }
        __syncthreads();
        for (int e = tid; e < 4096; e += 512) { const int tau = e >> 8, hp = (e >> 4) & 15, h = e & 15; float s = 0.f;
            for (int p = 0; p < 64; ++p) { const float2 c = CC[hp * 64 + p], w = LP[tau * 64 + p], b = BB[p * 16 + h];
                const float wr_ = c.x * w.x - c.y * w.y, wi_ = c.x * w.y + c.y * w.x; s += wr_ * b.x - wi_ * b.y; }
            if (tau == 0 && hp == h) s += a.in[12][(size_t)(l * 32 + g) * 16 + h];
            KT[e] = s; }
        __syncthreads();
        for (int e = tid; e < 32 * 384; e += 512) { const int rr = e / 384, col = e - rr * 384; const int i = 2 * part + (rr >> 4), hp = rr & 15; float v;
            if (col < 256) { const int j = col >> 4, h = col & 15; v = (j <= i) ? KT[((i - j) * 16 + hp) * 16 + h] : 0.f; }
            else { const int p = (col - 256) & 63; const float2 c = CC[hp * 64 + p], w = LP[(i + 1) * 64 + p]; v = (col < 320) ? (c.x * w.x - c.y * w.y) : -(c.x * w.y + c.y * w.x); }
            TM[((size_t)g * 256 + i * 16 + hp) * 384 + col] = (u16)f2bf(v); }
        for (int e = tid; e < 16 * 256; e += 512) { const int r = 16 * part + (e >> 8), col = e & 255, j = col >> 4, h = col & 15, p = r & 63;
            const float2 w = LP[(15 - j) * 64 + p], b = BB[p * 16 + h];
            const float v = (r < 64) ? (w.x * b.x - w.y * b.y) : (w.x * b.y + w.y * b.x);
            EM[((size_t)g * 128 + r) * 256 + col] = (u16)f2bf(v); }
        if (part == 0 && tid < 64) LAM[g * 64 + tid] = LP[16 * 64 + tid];
    }
    __syncthreads();
}

template <int MODE> __device__ __forceinline__ void row_pass(const Frame& F, const Args& a, int l) {
    float* wfx = (float*)(F.lds + 131072 - 32768);
    const float* g = nullptr; const float* bb = nullptr;
    if (MODE == 1) { g = a.in[18] + l * 1024; bb = a.in[19] + l * 1024; }
    if (MODE >= 2) { g = a.in[23] + l * 1024; bb = a.in[24] + l * 1024; }
    if (MODE == 0 || MODE == 2) {
        const float* win = a.in[1] + (size_t)(MODE == 0 ? 0 : l + 1) * DMOD * INTOT + 3584;
        __syncthreads();
        for (int e = F_TID; e < 8192; e += 512) { const int k = e >> 3, j = e & 7; wfx[j * 1024 + k] = win[(size_t)k * INTOT + j]; }
        __syncthreads();
    }
    const float* src = (MODE == 0) ? a.in[0] : (const float*)(F.ws + WS_PRE);
    const int gw = F.vcu * 8 + F_WAVE, NGW = F.G * 8;
    for (int m = gw; m < M; m += NGW) {
        const f32x4* xr = (const f32x4*)(src + (size_t)m * 1024) + F_LANE;
        f32x4 v[4];
#pragma unroll
        for (int j = 0; j < 4; ++j) v[j] = xr[64 * j];
        if (MODE != 0) {
            float s = 0.f;
#pragma unroll
            for (int j = 0; j < 4; ++j) s += (v[j].x + v[j].y) + (v[j].z + v[j].w);
            const float mean = wave_sum(s) * (1.f / 1024.f); float s2 = 0.f;
#pragma unroll
            for (int j = 0; j < 4; ++j) { v[j] = v[j] - mean; s2 += (v[j].x * v[j].x + v[j].y * v[j].y) + (v[j].z * v[j].z + v[j].w * v[j].w); }
            const float rstd = 1.f / sqrtf(wave_sum(s2) * (1.f / 1024.f) + LN_EPS);
#pragma unroll
            for (int j = 0; j < 4; ++j) { const f32x4 gg = ((const f32x4*)g)[64 * j + F_LANE], bv = ((const f32x4*)bb)[64 * j + F_LANE]; v[j] = v[j] * rstd * gg + bv; }
        }
        if (MODE == 1) {
            f32x4* o = (f32x4*)(F.ws + WS_PRE + (size_t)m * 4096) + F_LANE;
#pragma unroll
            for (int j = 0; j < 4; ++j) o[64 * j] = v[j];
            v2u* ob = (v2u*)(F.ws + WS_H1B + (size_t)m * 2048) + F_LANE;
#pragma unroll
            for (int j = 0; j < 4; ++j) { v2u w; w.x = pk2(v[j].x, v[j].y); w.y = pk2(v[j].z, v[j].w); ob[64 * j] = w; }
        } else if (MODE == 3) {
            f32x4* o = (f32x4*)(a.out + (size_t)m * 1024) + F_LANE;
#pragma unroll
            for (int j = 0; j < 4; ++j) o[64 * j] = v[j];
        } else {
            v2u* ob = (v2u*)(F.ws + WS_HB + (size_t)m * 2048) + F_LANE;
            v2u* ol = (v2u*)(F.ws + WS_HBL + (size_t)m * 2048) + F_LANE;
#pragma unroll
            for (int j = 0; j < 4; ++j) { v2u w; w.x = pk2(v[j].x, v[j].y); w.y = pk2(v[j].z, v[j].w); ob[64 * j] = w;
                if (MODE == 2) { v2u wl; wl.x = pk2(v[j].x - bflo(w.x), v[j].y - bfhi(w.x)); wl.y = pk2(v[j].z - bflo(w.y), v[j].w - bfhi(w.y)); ol[64 * j] = wl; } }
            float mine = 0.f;
#pragma unroll 1
            for (int c = 0; c < 8; ++c) { float s = 0.f;
#pragma unroll
                for (int j = 0; j < 4; ++j) { const f32x4 w = *(const f32x4*)(wfx + c * 1024 + 256 * j + 4 * F_LANE); s += (v[j].x * w.x + v[j].y * w.y) + (v[j].z * w.z + v[j].w * w.w); }
                s = wave_sum(s); if (F_LANE == c) mine = s; }
            if (F_LANE < 8) ((float*)(F.ws + WS_MISC + MISC_FXF))[(size_t)m * 8 + F_LANE] = mine;
        }
    }
}

template <int MT, int NT> __device__ __forceinline__ void mma_lds(f32x4 (&acc)[MT][NT], const u16* sA, int lda, const u16* sB, int ldb, int K, int lane) {
    const int r = lane & 15, q = lane >> 4;
    for (int k0 = 0; k0 < K; k0 += 32) {
        bf16x8 av[MT], bv[NT];
#pragma unroll
        for (int mt = 0; mt < MT; ++mt) av[mt] = *(const bf16x8*)(sA + (mt * 16 + r) * lda + k0 + q * 8);
#pragma unroll
        for (int nt = 0; nt < NT; ++nt) bv[nt] = *(const bf16x8*)(sB + (nt * 16 + r) * ldb + k0 + q * 8);
#pragma unroll
        for (int mt = 0; mt < MT; ++mt)
#pragma unroll
            for (int nt = 0; nt < NT; ++nt) acc[mt][nt] = __builtin_amdgcn_mfma_f32_16x16x32_bf16(av[mt], bv[nt], acc[mt][nt], 0, 0, 0);
    }
}

__device__ __forceinline__ void hgrn_load_scan(const float* ZF, int row0, int h, float* LG, float* KK, float* QT, int tid) {
    for (int idx = tid; idx < 64 * 32; idx += 512) { const int t = idx >> 5, k4 = (idx & 31) * 4;
        const f32x4 lf = *(const f32x4*)(ZF + (size_t)(row0 + t) * 512 + h * 128 + k4);
        *(f32x4*)(LG + t * 128 + k4) = lf;
        f32x4 kk; kk[0] = 1.f - __expf(lf[0]); kk[1] = 1.f - __expf(lf[1]); kk[2] = 1.f - __expf(lf[2]); kk[3] = 1.f - __expf(lf[3]);
        *(f32x4*)(KK + t * 128 + k4) = kk; }
    __syncthreads();
    const int k = tid & 127, q = tid >> 7; float run = 0.f;
    for (int t = 16 * q; t < 16 * q + 16; ++t) { run += LG[t * 128 + k]; LG[t * 128 + k] = run; }
    QT[q * 128 + k] = run;
    __syncthreads();
}
__device__ __forceinline__ void load_vT(const u16* ZI, int row0, int h, u16* BT, int tid) {
    for (int idx = tid; idx < 1024; idx += 512) { const int s = idx & 63, v8 = (idx >> 6) * 8;
        const v4u e = *(const v4u*)(ZI + (size_t)(row0 + s) * 512 + h * 128 + v8);
        BT[(v8 + 0) * 72 + s] = (u16)(e.x & 0xffff); BT[(v8 + 1) * 72 + s] = (u16)(e.x >> 16); BT[(v8 + 2) * 72 + s] = (u16)(e.y & 0xffff); BT[(v8 + 3) * 72 + s] = (u16)(e.y >> 16);
        BT[(v8 + 4) * 72 + s] = (u16)(e.z & 0xffff); BT[(v8 + 5) * 72 + s] = (u16)(e.z >> 16); BT[(v8 + 6) * 72 + s] = (u16)(e.w & 0xffff); BT[(v8 + 7) * 72 + s] = (u16)(e.w >> 16); }
}
__device__ __forceinline__ void hgrn_a_unit(const Frame& F, int u) {
    const int b = u >> 7, h = (u >> 5) & 3, c = u & 31, row0 = b * SEQL + c * 64, tid = F_TID, lane = F_LANE, w = F_WAVE;
    float* LG = (float*)F.lds; float* KK = (float*)(F.lds + 32768); float* QT = (float*)(F.lds + 65536);
    u16* AT = (u16*)(F.lds + 67584); u16* BT = (u16*)(F.lds + 67584 + 18432);
    hgrn_load_scan((const float*)(F.ws + WS_ZF), row0, h, LG, KK, QT, tid);
    load_vT((const u16*)(F.ws + WS_ZI), row0, h, BT, tid);
    { const int k = tid & 127, q = tid >> 7; float off = 0.f, glast = 0.f;
#pragma unroll
      for (int qq = 0; qq < 4; ++qq) { const float t_ = QT[qq * 128 + k]; glast += t_; if (qq < q) off += t_; }
      for (int s = 16 * q; s < 16 * q + 16; ++s) { const float gg = LG[s * 128 + k] + off; AT[k * 72 + s] = (u16)f2bf(KK[s * 128 + k] * __expf(glast - gg)); }
      if (q == 0) ((float*)(F.ws + WS_MISC + MISC_DEC))[u * 128 + k] = __expf(glast); }
    __syncthreads();
    f32x4 acc[2][4];
#pragma unroll
    for (int i = 0; i < 2; ++i)
#pragma unroll
        for (int j = 0; j < 4; ++j) acc[i][j] = (f32x4){0.f, 0.f, 0.f, 0.f};
    mma_lds<2, 4>(acc, AT + ((w >> 1) * 32) * 72, 72, BT + ((w & 1) * 64) * 72, 72, 64, lane);
    u16* KV = (u16*)(F.ws + WS_KV) + (size_t)u * 16384;
#pragma unroll
    for (int mt = 0; mt < 2; ++mt)
#pragma unroll
        for (int nt = 0; nt < 4; ++nt) { const int k0 = (w >> 1) * 32 + mt * 16 + (lane >> 4) * 4, v = (w & 1) * 64 + nt * 16 + (lane & 15);
            v2u o; o.x = pk2(acc[mt][nt][0], acc[mt][nt][1]); o.y = pk2(acc[mt][nt][2], acc[mt][nt][3]); *(v2u*)(KV + v * 128 + k0) = o; }
    __syncthreads();
}
__device__ __forceinline__ void hgrn_scan(const Frame& F) {
    const float* DEC = (const float*)(F.ws + WS_MISC + MISC_DEC);
    for (int gid = blockIdx.x * 512 + F_TID; gid < 32 * 4096; gid += F.G * 512) {
        const int bh = gid >> 12, e = (gid & 4095) * 4, k = e & 127;
        float s0 = 0.f, s1 = 0.f, s2 = 0.f, s3 = 0.f;
        u16* p = (u16*)(F.ws + WS_KV) + (size_t)bh * 32 * 16384 + e;
        const float* dp = DEC + (size_t)bh * 32 * 128 + k;
#pragma unroll 4
        for (int c = 0; c < 32; ++c) { const v2u kv = *(const v2u*)(p + (size_t)c * 16384); const f32x4 d = *(const f32x4*)(dp + c * 128);
            v2u o; o.x = pk2(s0, s1); o.y = pk2(s2, s3); *(v2u*)(p + (size_t)c * 16384) = o;
            s0 = d[0] * s0 + bflo(kv.x); s1 = d[1] * s1 + bfhi(kv.x); s2 = d[2] * s2 + bflo(kv.y); s3 = d[3] * s3 + bfhi(kv.y); }
    }
}
__device__ __forceinline__ void hgrn_c_unit(const Frame& F, const Args& a, int l, int u) {
    const int b = u >> 7, h = (u >> 5) & 3, c = u & 31, row0 = b * SEQL + c * 64, tid = F_TID, lane = F_LANE, w = F_WAVE;
    float* LG = (float*)F.lds; float* KK = (float*)(F.lds + 32768); float* QT = (float*)(F.lds + 65536);
    u16* ST = (u16*)F.lds; u16* BT = (u16*)(F.lds + 34816); u16* PP = (u16*)(F.lds + 53248);
    u16* QE = (u16*)(F.lds + 67584); u16* KE = (u16*)(F.lds + 84992); float* RS = (float*)(F.lds + 102400);
    hgrn_load_scan((const float*)(F.ws + WS_ZF), row0, h, LG, KK, QT, tid);
    { const int k = tid & 127, q = tid >> 7; float off = 0.f;
#pragma unroll
      for (int qq = 0; qq < 4; ++qq) { const float t_ = QT[qq * 128 + k]; if (qq < q) off += t_; }
      const u16* ZQ = (const u16*)(F.ws + WS_ZQ) + (size_t)row0 * 512 + h * 128 + k;
      for (int t = 16 * q; t < 16 * q + 16; ++t) { const float gg = LG[t * 128 + k] + off; const float qv = bf2f(ZQ[(size_t)t * 512]);
          QE[t * 136 + k] = (u16)f2bf(qv * __expf(gg)); KE[t * 136 + k] = (u16)f2bf(KK[t * 128 + k] * __expf(fminf(-gg, 80.f))); } }
    __syncthreads();
    { const u16* KV = (const u16*)(F.ws + WS_KV) + (size_t)u * 16384;
      for (int idx = tid; idx < 2048; idx += 512) { const int v = idx >> 4, k8 = (idx & 15) * 8; *(v4u*)(ST + v * 136 + k8) = *(const v4u*)(KV + v * 128 + k8); } }
    load_vT((const u16*)(F.ws + WS_ZI), row0, h, BT, tid);
    const int mt = w >> 1;
    { f32x4 sc[1][2]; sc[0][0] = (f32x4){0.f, 0.f, 0.f, 0.f}; sc[0][1] = (f32x4){0.f, 0.f, 0.f, 0.f};
      const int nt0 = (w & 1) * 2;
      mma_lds<1, 2>(sc, QE + mt * 16 * 136, 136, KE + nt0 * 16 * 136, 136, 128, lane);
#pragma unroll
      for (int i = 0; i < 2; ++i)
#pragma unroll
          for (int j = 0; j < 4; ++j) { const int t = mt * 16 + (lane >> 4) * 4 + j, s = (nt0 + i) * 16 + (lane & 15); PP[t * 72 + s] = (u16)f2bf(s <= t ? sc[0][i][j] : 0.f); } }
    __syncthreads();
    f32x4 acc[1][4];
#pragma unroll
    for (int i = 0; i < 4; ++i) acc[0][i] = (f32x4){0.f, 0.f, 0.f, 0.f};
    mma_lds<1, 4>(acc, QE + mt * 16 * 136, 136, ST + ((w & 1) * 64) * 136, 136, 128, lane);
    mma_lds<1, 4>(acc, PP + mt * 16 * 72, 72, BT + ((w & 1) * 64) * 72, 72, 64, lane);
#pragma unroll
    for (int j = 0; j < 4; ++j) { float ss = 0.f;
#pragma unroll
        for (int i = 0; i < 4; ++i) ss += acc[0][i][j] * acc[0][i][j];
        ss += __shfl_xor(ss, 1); ss += __shfl_xor(ss, 2); ss += __shfl_xor(ss, 4); ss += __shfl_xor(ss, 8);
        if ((lane & 15) == 0) RS[(mt * 16 + (lane >> 4) * 4 + j) * 2 + (w & 1)] = ss; }
    __syncthreads();
    const float* nw = a.in[3] + l * 128;
#pragma unroll
    for (int j = 0; j < 4; ++j) { const int t = mt * 16 + (lane >> 4) * 4 + j; const float r = rsqrtf((RS[t * 2] + RS[t * 2 + 1]) * (1.f / 128.f) + RMS_EPS);
        const size_t ro = (size_t)(row0 + t) * 512 + h * 128;
#pragma unroll
        for (int i = 0; i < 4; ++i) { const int v = (w & 1) * 64 + i * 16 + (lane & 15); const float gt = bf2f(((const u16*)(F.ws + WS_ZG))[ro + v]);
            ((u16*)(F.ws + WS_YA))[ro + v] = (u16)f2bf(acc[0][i][j] * r * nw[v] * gt * sigm(gt)); } }
    __syncthreads();
}

__device__ __forceinline__ void load_tile16(u16* dst, int dpitch, const u16* src, size_t spitch, int rows, int cols8, int tid) {
    for (int idx = tid; idx < rows * cols8; idx += 512) { const int r = idx / cols8, c8 = idx - r * cols8; *(v4u*)(dst + r * dpitch + c8 * 8) = *(const v4u*)(src + (size_t)r * spitch + c8 * 8); }
}
__device__ __forceinline__ void s5_1_unit(const Frame& F, int unit) {
    const int g = unit >> 3, rt = unit & 7, tid = F_TID, lane = F_LANE, w = F_WAVE;
    u16* A = (u16*)F.lds; u16* B = (u16*)(F.lds + 67584);
    load_tile16(A, 264, (const u16*)(F.ws + WS_SU) + ((size_t)g * 1024 + rt * 128) * 256, 256, 128, 32, tid);
    load_tile16(B, 264, (const u16*)(F.dout + DO_EM) + (size_t)g * 128 * 256, 256, 128, 32, tid);
    __syncthreads();
    f32x4 acc[2][4];
#pragma unroll
    for (int i = 0; i < 2; ++i)
#pragma unroll
        for (int j = 0; j < 4; ++j) acc[i][j] = (f32x4){0.f, 0.f, 0.f, 0.f};
    mma_lds<2, 4>(acc, A + ((w >> 1) * 32) * 264, 264, B + ((w & 1) * 64) * 264, 264, 256, lane);
    u16* SE = (u16*)(F.ws + WS_SE);
#pragma unroll
    for (int mt = 0; mt < 2; ++mt)
#pragma unroll
        for (int nt = 0; nt < 4; ++nt)
#pragma unroll
            for (int j = 0; j < 4; ++j) { const int n = rt * 128 + (w >> 1) * 32 + mt * 16 + (lane >> 4) * 4 + j, r = (w & 1) * 64 + nt * 16 + (lane & 15);
                SE[((size_t)n * 32 + g) * 128 + r] = (u16)f2bf(acc[mt][nt][j]); }
    __syncthreads();
}
__device__ __forceinline__ void s5_scan(const Frame& F) {
    const float2* LAM = (const float2*)(F.dout + DO_LAM);
    float2* XL = (float2*)F.lds;
    const int tid = F_TID, seg = __builtin_amdgcn_readfirstlane(tid >> 6), p = tid & 63;
    for (int pair = blockIdx.x; pair < 256; pair += F.G) {
        const int b = pair >> 5, g = pair & 31; const float2 lm = LAM[g * 64 + p];
        u16* base = (u16*)(F.ws + WS_SE) + ((size_t)(b * 128 + seg * 16) * 32 + g) * 128 + p;
        float er[16], ei[16];
#pragma unroll
        for (int i = 0; i < 16; ++i) { const u16* q = base + (size_t)i * 4096; er[i] = bf2f(q[0]); ei[i] = bf2f(q[64]); }
        float sr = 0.f, si = 0.f;
#pragma unroll
        for (int i = 0; i < 16; ++i) { const float nr = lm.x * sr - lm.y * si + er[i], ni = lm.x * si + lm.y * sr + ei[i]; er[i] = sr; ei[i] = si; sr = nr; si = ni; }
        XL[seg * 64 + p] = make_float2(sr, si);
        float pr = lm.x, pi = lm.y;
#pragma unroll
        for (int k = 0; k < 4; ++k) { const float nr = pr * pr - pi * pi, ni = 2.f * pr * pi; pr = nr; pi = ni; }
        __syncthreads();
        float ar = 0.f, ai = 0.f;
        for (int s2 = 0; s2 < seg; ++s2) { const float2 t = XL[s2 * 64 + p]; const float nr = pr * ar - pi * ai + t.x, ni = pr * ai + pi * ar + t.y; ar = nr; ai = ni; }
        float wr_ = 1.f, wi_ = 0.f;
#pragma unroll
        for (int i = 0; i < 16; ++i) { u16* q = base + (size_t)i * 4096; q[0] = (u16)f2bf(wr_ * ar - wi_ * ai + er[i]); q[64] = (u16)f2bf(wr_ * ai + wi_ * ar + ei[i]);
            const float nr = wr_ * lm.x - wi_ * lm.y, ni = wr_ * lm.y + wi_ * lm.x; wr_ = nr; wi_ = ni; }
        __syncthreads();
    }
}
__device__ __forceinline__ void s5_2_unit(const Frame& F, int unit) {
    const int g = unit >> 3, rt = unit & 7, tid = F_TID, lane = F_LANE, w = F_WAVE;
    u16* A = (u16*)F.lds; u16* B = (u16*)(F.lds + 34816);
    f32x4 acc[2][8];
#pragma unroll
    for (int i = 0; i < 2; ++i)
#pragma unroll
        for (int j = 0; j < 8; ++j) acc[i][j] = (f32x4){0.f, 0.f, 0.f, 0.f};
    for (int kc = 0; kc < 3; ++kc) {
        __syncthreads();
        if (kc < 2) load_tile16(A, 136, (const u16*)(F.ws + WS_SU) + ((size_t)g * 1024 + rt * 128) * 256 + kc * 128, 256, 128, 16, tid);
        else        load_tile16(A, 136, (const u16*)(F.ws + WS_SE) + ((size_t)(rt * 128) * 32 + g) * 128, 4096, 128, 16, tid);
        load_tile16(B, 136, (const u16*)(F.dout + DO_TM) + (size_t)g * 256 * 384 + kc * 128, 384, 256, 16, tid);
        __syncthreads();
        mma_lds<2, 8>(acc, A + ((w >> 1) * 32) * 136, 136, B + ((w & 1) * 128) * 136, 136, 128, lane);
    }
    u16* YG = (u16*)(F.dout + DO_YG);
#pragma unroll
    for (int mt = 0; mt < 2; ++mt)
#pragma unroll
        for (int nt = 0; nt < 8; ++nt)
#pragma unroll
            for (int j = 0; j < 4; ++j) { const int n = rt * 128 + (w >> 1) * 32 + mt * 16 + (lane >> 4) * 4 + j, i = (w & 1) * 8 + nt, hp = lane & 15;
                const float y = acc[mt][nt][j]; const float z = 0.7978845608028654f * (y + 0.044715f * y * y * y);
                const float th = 1.f - 2.f / (__expf(2.f * z) + 1.f);
                YG[((size_t)n * 16 + i) * 512 + 16 * g + hp] = (u16)f2bf(0.5f * y * (1.f + th)); }
    __syncthreads();
}

#ifndef REP_MIX
#define REP_MIX 1
#endif
#ifndef REP_SYNC
#define REP_SYNC 1
#endif
#ifndef REP_G1
#define REP_G1 1
#endif
#define GSYNC() do { for (int rs_ = 0; rs_ < REP_SYNC; ++rs_) xcd_barrier(xbar); } while (0)
__global__ void __launch_bounds__(512, 2) mega_fwd(Args a) {
    extern __shared__ __attribute__((aligned(16))) unsigned char lds[];
    cg::grid_group grid = cg::this_grid();
    Frame F; F.lds = lds; F.ws = a.ws; F.dout = (unsigned char*)a.out;
    F.G = gridDim.x; { const int bx = blockIdx.x; F.vcu = (F.G % 8 == 0) ? (bx % 8) * (F.G / 8) + bx / 8 : bx; }
    PG8_LAS unsigned char* glds = (PG8_LAS unsigned char*)lds;
    typedef pg8::bf16_t pb;
    unsigned char* ws = a.ws; unsigned char* dq = F.dout;

    unsigned* barw = (unsigned*)(ws + WS_MISC + 3 * MiB);
    volatile LAS unsigned* xst = (volatile LAS unsigned*)((LAS unsigned char*)lds + 147392);
    if (threadIdx.x < 16) xst[threadIdx.x] = 0u;
    if (blockIdx.x == 0) for (int i = threadIdx.x; i < XCD_BAR_WORDS; i += 512) barw[i] = 0u;
    if (blockIdx.x == 0) { float* LB = (float*)(ws + WS_MISC + MISC_LB);
        for (int k = F_TID; k < 512; k += 512) { const float a0 = a.in[2][k], a1 = a.in[2][512 + k], mx = fmaxf(a0, a1), e0 = expf(a0 - mx), e1 = expf(a1 - mx); LB[k] = 0.f; LB[512 + k] = e1 / (e0 + e1); } }
#ifndef NO_PRO
    convert_weights(F, a, 0);
    s5_mats(F, a, 0);
#endif
#ifndef NO_ROW
    row_pass<0>(F, a, 0);
#endif
    grid.sync();
    const XcdBarrier xbar = xcd_barrier_post(barw, xst);

    for (int l = 0; l < 2; ++l) {
#ifndef NO_GEMM
        { pg8::Gemm g{(const pb*)(ws + WS_HB), (const pb*)(dq + DO_WIN), M, 4096, 1024}; pg8::StaticOrder S; S.init(M, 4096, F.G, (int)blockIdx.x);
          pg8::EpiIn E{ws, (const float*)(ws + WS_MISC + MISC_LB) + l * 512, attn_body::C2};
          for (int rep_ = 0; rep_ < REP_G1; ++rep_) pg8::gemm_phase<pg8::EpiIn, pg8::StaticOrder, true, true>(glds, g, S, E); }
#endif
        GSYNC();
#ifndef NO_ATTN
        { const attn_body::AttnTensors AT{(const attn_body::bf16*)(ws + WS_FQ), (const attn_body::bf16*)(ws + WS_FK), (const attn_body::bf16*)(ws + WS_FV), (attn_body::bf16*)(ws + WS_YB),
                                          (const float*)(ws + WS_MISC + MISC_FXF), a.in[4] + l * 8};
          const attn_body::StaticOrder S((int)F.G, (int)blockIdx.x);
#ifdef REP_ATTN
          { const attn_body::AttnTensors AT2{(const attn_body::bf16*)(ws + WS_FQ), (const attn_body::bf16*)(ws + WS_FK), (const attn_body::bf16*)(ws + WS_FV), (attn_body::bf16*)(dq + DO_YG),
                                          (const float*)(ws + WS_MISC + MISC_FXF), a.in[4] + l * 8};
            attn_body::attn_phase<attn_body::StaticOrder>((char*)lds, AT2, S); }
#endif
          attn_body::attn_phase<attn_body::StaticOrder>((char*)lds, AT, S); }
#endif
        __syncthreads();
#ifndef NO_MIX
        for (int rep_ = 0; rep_ < REP_MIX; ++rep_) {
        for (int u = F.vcu; u < 1024; u += F.G) hgrn_a_unit(F, u);
        for (int u = F.vcu; u < 256; u += F.G) s5_1_unit(F, u);
        }
#endif
        GSYNC();
#ifndef NO_MIX
        hgrn_scan(F);
        s5_scan(F);
#endif
        GSYNC();
#ifndef NO_MIX
        for (int rep_ = 0; rep_ < REP_MIX; ++rep_) {
        for (int u = F.vcu; u < 1024; u += F.G) hgrn_c_unit(F, a, l, u);
        for (int u = F.vcu; u < 256; u += F.G) s5_2_unit(F, u);
        }
#endif
        GSYNC();
#ifndef NO_GEMM2
        { pg8::Gemm g{(const pb*)(dq + DO_YG), (const pb*)(dq + DO_WGLU), M, 512, 512}; pg8::StaticOrder S; S.init(M, 512, F.G, (int)blockIdx.x);
          pg8::EpiGlu E{(const pb*)(dq + DO_YG), (pb*)(ws + WS_YC)};
          pg8::gemm_phase<pg8::EpiGlu, pg8::StaticOrder, true, true>(glds, g, S, E); }
        { pg8::Gemm g{(const pb*)(ws + WS_HB), (const pb*)(dq + DO_WIN) + (size_t)4096 * 1024, M, 3072, 1024}; pg8::StaticOrder S; S.init(M, 3072, F.G, (int)blockIdx.x);
          pg8::EpiGate E{(pb*)(ws + WS_GATES)};
          pg8::gemm_phase<pg8::EpiGate, pg8::StaticOrder, true, true>(glds, g, S, E); }
        GSYNC();
        { pg8::Gemm g{(const pb*)(ws + WS_YA), (const pb*)(dq + DO_WBR), 3 * M, 3072, 512}; pg8::BranchOrder S; S.init(F.G, (int)blockIdx.x);
          pg8::EpiBranch E{(const pb*)(ws + WS_GATES), (pb*)(ws + WS_MERGED)};
          pg8::gemm_phase<pg8::EpiBranch, pg8::BranchOrder, true, true>(glds, g, S, E); }
        GSYNC();
        { pg8::Gemm g{(const pb*)(ws + WS_MERGED), (const pb*)(dq + DO_WOUT), M, 1024, 1024}; pg8::StaticOrder S; S.init(M, 1024, F.G, (int)blockIdx.x);
          pg8::EpiRes E{l == 0 ? a.in[0] : nullptr, (const pb*)(ws + WS_HB), (const pb*)(ws + WS_HBL), (float*)(ws + WS_PRE)};
          pg8::gemm_phase<pg8::EpiRes, pg8::StaticOrder, true, true>(glds, g, S, E); }
        GSYNC();
#endif
#ifndef NO_ROW
        row_pass<1>(F, a, l);
#endif
        GSYNC();
#ifndef NO_GEMM3
        { pg8::Gemm g{(const pb*)(ws + WS_H1B), (const pb*)(dq + DO_WGU), M, 5632, 1024}; pg8::StaticOrder S; S.init(M, 5632, F.G, (int)blockIdx.x);
          pg8::EpiSwiglu E{(pb*)(ws + WS_FFH)};
          for (int rep_ = 0; rep_ < REP_G1; ++rep_) pg8::gemm_phase<pg8::EpiSwiglu, pg8::StaticOrder, true, true>(glds, g, S, E); }
        GSYNC();
        { pg8::Gemm g{(const pb*)(ws + WS_FFH), (const pb*)(dq + DO_WDN), M, 1024, FFN_H}; pg8::StaticOrder S; S.init(M, 1024, F.G, (int)blockIdx.x);
          pg8::EpiRes E{(const float*)(ws + WS_PRE), nullptr, nullptr, (float*)(ws + WS_PRE)};
          pg8::gemm_phase<pg8::EpiRes, pg8::StaticOrder, true, true>(glds, g, S, E); }
        GSYNC();
#endif
        if (l == 0) {
#ifndef NO_PRO
            convert_weights(F, a, 1); s5_mats(F, a, 1);
#endif
#ifndef NO_ROW
            row_pass<2>(F, a, 0);
#endif
            GSYNC(); }
#ifndef NO_ROW
        else row_pass<3>(F, a, 1);
#endif
    }
}

extern "C" void kernel_launch(void* const* d_in, const int* in_sizes, int n_in, void* d_out, int out_size, void* d_ws, size_t ws_size, hipStream_t stream) {
    static int grid = 0;
    if (grid == 0) {
        int dev = 0, cus = 0, per_cu = 0;
        if (hipGetDevice(&dev) != hipSuccess || hipDeviceGetAttribute(&cus, hipDeviceAttributeMultiprocessorCount, dev) != hipSuccess) { fprintf(stderr, "kernel_launch: device query failed\n"); grid = -1; return; }
        if (hipFuncSetAttribute((const void*)mega_fwd, hipFuncAttributeMaxDynamicSharedMemorySize, LDS_BYTES) != hipSuccess) { fprintf(stderr, "kernel_launch: hipFuncSetAttribute failed\n"); grid = -1; return; }
        if (hipOccupancyMaxActiveBlocksPerMultiprocessor(&per_cu, (const void*)mega_fwd, 512, LDS_BYTES) != hipSuccess || per_cu < 1) { fprintf(stderr, "kernel_launch: occupancy query says %d blocks per CU\n", per_cu); grid = -1; return; }
        grid = cus;
        if (n_in != 25 || out_size != M * DMOD || ws_size < 256 * MiB) { fprintf(stderr, "kernel_launch: unexpected shapes (n_in %d out %d ws %zu)\n", n_in, out_size, ws_size); grid = -1; return; }
    }
    if (grid < 0) return;
    Args a{};
    for (int i = 0; i < 25; ++i) a.in[i] = (const float*)d_in[i];
    a.out = (float*)d_out; a.ws = (unsigned char*)d_ws;
    void* args[] = {&a};
    hipError_t e = hipLaunchCooperativeKernel((void*)mega_fwd, dim3(grid), dim3(512), args, LDS_BYTES, stream);
    if (e != hipSuccess) fprintf(stderr, "kernel_launch: cooperative launch failed: %s (grid %d)\n", hipGetErrorString(e), grid);
}
```

```cpp
#include <hip/hip_runtime.h>
#include <hip/hip_cooperative_groups.h>
#include <cstdio>
#include <cstdint>
namespace cg = cooperative_groups;

namespace pg8 {
#define PG8_LAS __attribute__((address_space(3)))
typedef unsigned short bf16_t;
typedef short bf16x8 __attribute__((ext_vector_type(8)));
typedef float f32x4 __attribute__((ext_vector_type(4)));
typedef unsigned u32x4 __attribute__((ext_vector_type(4)));
constexpr int BM = 256, BK = 64, HALF = 128, HTB = HALF * BK * 2  , STAGE_BYTES = 8 * HTB, NXCD = 8, WGM = 8;

__host__ __device__ __forceinline__ int lds_byte(int r, int c) { const int st = (r >> 4) * 2 + (c >> 5), rr = r & 15, cc = c & 31, ob = rr * 64 + cc * 2; return st * 1024 + (ob ^ (((ob >> 9) & 1) << 5)); }
__host__ __device__ __forceinline__ void stage_rc(int b, int& R, int& C) { const int st = b / 1024, sb = b % 1024, swz = sb ^ (((sb >> 9) & 1) << 5); R = (st >> 1) * 16 + swz / 64; C = (st & 1) * 32 + (swz % 64) / 2; }
__host__ __device__ __forceinline__ int perm32(int rho) { const int n = rho >> 4, i = rho & 15; return 8 * (i >> 2) + 4 * n + (i & 3); }

struct Unit { int pm, pn; };
struct Gemm { const bf16_t* A; const bf16_t* Bt; int M, N, K; };

struct StaticOrder {
    int nM, nN, nwg, G, c;
    __host__ __device__ void init(int M, int N, int G_, int c_) { nM = M / BM; nN = N / BM; nwg = nM * nN; G = G_; c = c_; }
    __host__ __device__ bool next(int i, Unit& u) const {
        const long L = (long)i * G + c; if (L >= nwg) return false;
        int wgid = (int)L; { const int q = nwg / NXCD, r = nwg % NXCD, xcd = wgid % NXCD, off = wgid / NXCD; wgid = (xcd < r ? xcd * (q + 1) : r * (q + 1) + (xcd - r) * q) + off; }
        const int nig = WGM * nN, gid = wgid / nig, fm = gid * WGM, gsz = (nM - fm) < WGM ? (nM - fm) : WGM;
        u.pm = fm + ((wgid % nig) % gsz); u.pn = (wgid % nig) / gsz; return true;
    }
    __device__ __forceinline__ void a_ready(const Unit&) const {}
    __device__ __forceinline__ void done(const Unit&) const {}
};

__device__ __forceinline__ unsigned cvt_pk_bf16(float lo, float hi) { unsigned r; asm volatile("v_cvt_pk_bf16_f32 %0, %1, %2" : "=v"(r) : "v"(lo), "v"(hi)); return r; }
typedef float f32x2 __attribute__((ext_vector_type(2)));

template <class Epi, class Sched, bool ALIGN_EPI = false, bool SP2 = false>
__device__ __forceinline__ void gemm_phase(PG8_LAS unsigned char* lds, const Gemm g, const Sched& S, const Epi& E) {
    int tid_o = threadIdx.x; asm volatile("" : "+v"(tid_o));
    const int tid = tid_o, wid = __builtin_amdgcn_readfirstlane(tid >> 6), lane = tid & 63, wr = wid >> 2, wc = wid & 3, fr = lane & 15, fq = lane >> 4;
    const int K = g.K, nt = K / BK;
    unsigned voffA[2], voffB[2];
#pragma unroll
    for (int i = 0; i < 2; ++i) { int R, C; stage_rc(tid * 16 + i * 8192, R, C); const int Rb = Epi::PERM ? ((R & ~31) + perm32(R & 31)) : R;
        voffA[i] = (unsigned)(R * K + C) * 2u; voffB[i] = (unsigned)(Rb * K + C) * 2u; }
    const size_t kstep = (size_t)(BK * 2);
    const size_t hstep = (size_t)HALF * K * 2;
    const size_t tstep = 2 * hstep;
    const unsigned ldsw = (unsigned)wid * 1024u;
    const int aoff = lds_byte(wr * 64 + fr, fq * 8), boff = lds_byte(wc * 32 + fr, fq * 8);
#define PG8_SA(b, h) (((b) * 2 + (h)) * HTB)
#define PG8_SB(b, h) ((4 + (b) * 2 + (h)) * HTB)
#define PG8_STAGE(bufoff, gbase, voff) do { _Pragma("unroll") for (int _i = 0; _i < 2; ++_i) \
        __builtin_amdgcn_global_load_lds((const unsigned*)((const char*)(gbase) + (voff)[_i]), (PG8_LAS unsigned*)(lds + (bufoff) + ldsw + _i * 8192), 16, 0, 0); } while (0)
#define PG8_LDA(dst, b, h) do { _Pragma("unroll") for (int m = 0; m < 4; ++m) _Pragma("unroll") for (int k = 0; k < 2; ++k) dst[m][k] = *(const PG8_LAS bf16x8*)(lds + PG8_SA(b, h) + aoff + m * 2048 + k * 1024); } while (0)
#define PG8_LDB(dst, b, h) do { _Pragma("unroll") for (int n = 0; n < 2; ++n) _Pragma("unroll") for (int k = 0; k < 2; ++k) dst[n][k] = *(const PG8_LAS bf16x8*)(lds + PG8_SB(b, h) + boff + n * 2048 + k * 1024); } while (0)
#define PG8_MMA(ai, bj, At, Bt) do { __builtin_amdgcn_s_setprio(1); _Pragma("unroll") for (int m = 0; m < 4; ++m) _Pragma("unroll") for (int n = 0; n < 2; ++n) _Pragma("unroll") for (int k = 0; k < 2; ++k) \
        acc[ai][bj][m][n] = __builtin_amdgcn_mfma_f32_16x16x32_bf16(Bt[n][k], At[m][k], acc[ai][bj][m][n], 0, 0, 0); __builtin_amdgcn_s_setprio(0); } while (0)
#define PG8_WAIT_V(n) asm volatile("s_waitcnt vmcnt(" #n ")" ::: "memory")
#define PG8_WAIT_L(n) asm volatile("s_waitcnt lgkmcnt(" #n ")" ::: "memory")
#define PG8_BAR __builtin_amdgcn_s_barrier()
#define PG8_SCHED __builtin_amdgcn_sched_barrier(0)
    Unit cur, nxt; int ui = 0;
    if (!S.next(0, cur)) return;
    f32x4 acc[2][2][4][2];
#pragma unroll
    for (int a = 0; a < 2; ++a)
#pragma unroll
        for (int b = 0; b < 2; ++b)
#pragma unroll
            for (int m = 0; m < 4; ++m)
#pragma unroll
                for (int n = 0; n < 2; ++n) acc[a][b][m][n] = (f32x4){0.f, 0.f, 0.f, 0.f};
    bf16x8 At[4][2], B0[2][2], B1[2][2];
    const char* cA = (const char*)g.A + (size_t)cur.pm * tstep; const char* cB = (const char*)g.Bt + (size_t)cur.pn * tstep;
    S.a_ready(cur);
    if constexpr (SP2) {
        PG8_STAGE(PG8_SB(0, 0), cB, voffB); PG8_STAGE(PG8_SB(0, 1), cB + hstep, voffB); PG8_STAGE(PG8_SA(0, 0), cA, voffA); PG8_STAGE(PG8_SA(0, 1), cA + hstep, voffA);
        if (wr == 1) PG8_BAR;
        PG8_WAIT_V(2); PG8_BAR;
        PG8_STAGE(PG8_SB(1, 0), cB + kstep, voffB); PG8_STAGE(PG8_SA(1, 0), cA + kstep, voffA); PG8_STAGE(PG8_SB(1, 1), cB + hstep + kstep, voffB);
        PG8_WAIT_V(6); PG8_BAR;
    } else {
        PG8_STAGE(PG8_SB(0, 0), cB, voffB); PG8_STAGE(PG8_SA(0, 0), cA, voffA); PG8_STAGE(PG8_SB(0, 1), cB + hstep, voffB); PG8_STAGE(PG8_SA(0, 1), cA + hstep, voffA);
        if (wr == 1) PG8_BAR;
        PG8_WAIT_V(4); PG8_BAR;
        PG8_STAGE(PG8_SB(1, 0), cB + kstep, voffB); PG8_STAGE(PG8_SA(1, 0), cA + kstep, voffA); PG8_STAGE(PG8_SB(1, 1), cB + hstep + kstep, voffB);
        PG8_WAIT_V(6); PG8_BAR;
    }
    for (;;) {
        const bool has_next = S.next(ui + 1, nxt);
        const char* nA = has_next ? (const char*)g.A + (size_t)nxt.pm * tstep : cA; const char* nB = has_next ? (const char*)g.Bt + (size_t)nxt.pn * tstep : cB;
        for (int t = 0; t < nt; t += 2) {
            const bool last = (t == nt - 2);
            const char* a1 = cA + (size_t)(t + 1) * kstep;
            const char* a2 = last ? nA : cA + (size_t)(t + 2) * kstep; const char* b2 = last ? nB : cB + (size_t)(t + 2) * kstep;
            const char* a3 = a2 + kstep; const char* b3 = b2 + kstep;
            if (last && has_next) S.a_ready(nxt);
            if constexpr (SP2) {
            PG8_LDB(B0, 0, 0); PG8_LDB(B1, 0, 1); PG8_SCHED; PG8_LDA(At, 0, 0); PG8_STAGE(PG8_SA(1, 1), a1 + hstep, voffA);
            PG8_WAIT_V(8); PG8_WAIT_L(0); PG8_BAR; PG8_MMA(0, 0, At, B0); PG8_MMA(0, 1, At, B1); PG8_BAR; PG8_SCHED;
            PG8_LDA(At, 0, 1); PG8_STAGE(PG8_SB(0, 0), b2, voffB); PG8_STAGE(PG8_SB(0, 1), b2 + hstep, voffB); PG8_STAGE(PG8_SA(0, 0), a2, voffA);
            PG8_WAIT_V(8); PG8_WAIT_L(0); PG8_BAR; PG8_MMA(1, 0, At, B0); PG8_MMA(1, 1, At, B1); PG8_BAR; PG8_SCHED;
            PG8_LDB(B0, 1, 0); PG8_LDB(B1, 1, 1); PG8_SCHED; PG8_LDA(At, 1, 0); PG8_STAGE(PG8_SA(0, 1), a2 + hstep, voffA);
            PG8_WAIT_V(8); PG8_WAIT_L(0); PG8_BAR; PG8_MMA(0, 0, At, B0); PG8_MMA(0, 1, At, B1); PG8_BAR; PG8_SCHED;
            PG8_LDA(At, 1, 1); PG8_STAGE(PG8_SB(1, 0), b3, voffB); PG8_STAGE(PG8_SB(1, 1), b3 + hstep, voffB); PG8_STAGE(PG8_SA(1, 0), a3, voffA);
            PG8_WAIT_V(8); PG8_WAIT_L(0); PG8_BAR; PG8_MMA(1, 0, At, B0); PG8_MMA(1, 1, At, B1); PG8_BAR; PG8_SCHED;
            } else {
            PG8_LDB(B0, 0, 0); PG8_SCHED; PG8_LDA(At, 0, 0); PG8_STAGE(PG8_SA(1, 1), a1 + hstep, voffA);
            PG8_WAIT_L(8); PG8_BAR; PG8_WAIT_L(0); PG8_MMA(0, 0, At, B0); PG8_BAR; PG8_SCHED;
            PG8_LDB(B1, 0, 1); PG8_STAGE(PG8_SB(0, 0), b2, voffB);
            PG8_BAR; PG8_WAIT_L(0); PG8_MMA(0, 1, At, B1); PG8_BAR;
            PG8_LDA(At, 0, 1); PG8_STAGE(PG8_SA(0, 0), a2, voffA);
            PG8_BAR; PG8_WAIT_L(0); PG8_MMA(1, 0, At, B0); PG8_BAR; PG8_SCHED;
            PG8_STAGE(PG8_SB(0, 1), b2 + hstep, voffB);
            PG8_WAIT_V(6); PG8_BAR; PG8_MMA(1, 1, At, B1); PG8_BAR;
            PG8_LDB(B0, 1, 0); PG8_SCHED; PG8_LDA(At, 1, 0); PG8_STAGE(PG8_SA(0, 1), a2 + hstep, voffA);
            PG8_WAIT_L(8); PG8_BAR; PG8_WAIT_L(0); PG8_MMA(0, 0, At, B0); PG8_BAR; PG8_SCHED;
            PG8_LDB(B1, 1, 1); PG8_STAGE(PG8_SB(1, 0), b3, voffB);
            PG8_BAR; PG8_WAIT_L(0); PG8_MMA(0, 1, At, B1); PG8_BAR;
            PG8_LDA(At, 1, 1); PG8_STAGE(PG8_SA(1, 0), a3, voffA);
            PG8_BAR; PG8_WAIT_L(0); PG8_MMA(1, 0, At, B0); PG8_BAR; PG8_SCHED;
            PG8_STAGE(PG8_SB(1, 1), b3 + hstep, voffB);
            PG8_WAIT_V(6); PG8_BAR; PG8_MMA(1, 1, At, B1); PG8_BAR;
            }
        }
        if constexpr (ALIGN_EPI) { if (wr == 0) PG8_BAR; }
        if constexpr (!Epi::AFTER_DRAIN) { E(acc, cur, wr, wc, fr, fq); S.done(cur); }
        if (!has_next) break;
        if constexpr (!Epi::KEEP_ACC) {
#pragma unroll
        for (int a = 0; a < 2; ++a)
#pragma unroll
            for (int b = 0; b < 2; ++b)
#pragma unroll
                for (int m = 0; m < 4; ++m)
#pragma unroll
                    for (int n = 0; n < 2; ++n) acc[a][b][m][n] = (f32x4){0.f, 0.f, 0.f, 0.f};
        }
        cur = nxt; cA = nA; cB = nB; ++ui;
        if constexpr (ALIGN_EPI) { if (wr == 1) PG8_BAR; }
    }
    PG8_WAIT_V(0);
    if constexpr (!ALIGN_EPI) { if (wr == 0) PG8_BAR; }
    PG8_BAR;
    if constexpr (Epi::AFTER_DRAIN) { E.fused(acc, cur, wr, wc, fr, fq, lds, wid, lane); S.done(cur); }
#undef PG8_SA
#undef PG8_SB
#undef PG8_STAGE
#undef PG8_LDA
#undef PG8_LDB
#undef PG8_MMA
#undef PG8_WAIT_V
#undef PG8_WAIT_L
#undef PG8_BAR
#undef PG8_SCHED
}
}
#include <hip/hip_bf16.h>
#include <cmath>
namespace attn_body {
using bf16=__hip_bfloat16;
using bf16x8=__attribute__((ext_vector_type(8)))short;
using s16x4=__attribute__((ext_vector_type(4)))short;
using f32x16=__attribute__((ext_vector_type(16)))float;
using u32x4=__attribute__((ext_vector_type(4)))unsigned;
using f32x4b=__attribute__((ext_vector_type(4)))float;
constexpr int BATCH=8,NHEAD=8,SEQ=2048,D=64,DM=NHEAD*D;
constexpr int NW=8,QBLK=32,QB=QBLK*NW,KVBLK=64,NQB=SEQ/QB;
constexpr int ATTN_PITCH=DM, ATTN_UNIT_ROWS=QB;
__device__ __forceinline__ int crow(int r,int hi){return (r&3)+8*(r>>2)+4*hi;}
#define SBAR() __builtin_amdgcn_sched_barrier(0)
__device__ __forceinline__ void cmask(f32x16&p0,f32x16&p1,int jb,int qrel,int hi){
  const float NEG=-INFINITY; int kb=64*jb+4*hi;
  #pragma unroll
  for(int r=0;r<16;++r){int kv=kb+(r&3)+8*(r>>2); if(kv>qrel)p0[r]=NEG; if(kv+32>qrel)p1[r]=NEG;}
}

constexpr int NSLOT=3, SLOTB=8192;
constexpr int LDS_K=0, LDS_V=NSLOT*SLOTB, LDS_WS=2*NSLOT*SLOTB, LDS_OST=LDS_WS+NW*64*4, LDS_BIAS=LDS_OST+NW*4096, LDS_SCAN=LDS_BIAS+SEQ*4, LDS_BYTES=LDS_SCAN+256;
constexpr float C2=0.125f*1.4426950408889634f;
__device__ __forceinline__ void glds16(const void*gsrc,unsigned lds_dst){unsigned keep;
  asm volatile("s_mov_b32 %0, m0\n\ts_mov_b32 m0, %2\n\ts_nop 0\n\tglobal_load_lds_dwordx4 %1, off\n\ts_mov_b32 m0, %0":"=&s"(keep):"v"(gsrc),"s"(lds_dst):"memory");}
__device__ __forceinline__ float max3f(float a,float b,float c){float r;asm("v_max3_f32 %0, %1, %2, %3":"=v"(r):"v"(a),"v"(b),"v"(c));return r;}
__device__ __forceinline__ float max2f(float a,float b){float r;asm("v_max_f32_e32 %0, %1, %2":"=v"(r):"v"(a),"v"(b));return r;}
__device__ __forceinline__ float fadd_s(float a,float b){float r;asm("v_add_f32_e32 %0, %1, %2":"=v"(r):"v"(a),"v"(b));return r;}
__device__ __forceinline__ float fsub_s(float a,float b){float r;asm("v_sub_f32_e32 %0, %1, %2":"=v"(r):"v"(a),"v"(b));return r;}
typedef float f32x2_t __attribute__((ext_vector_type(2))); typedef __bf16 bf16x2_t __attribute__((ext_vector_type(2)));
__device__ __forceinline__ unsigned cvtpk_s(float lo,float hi){f32x2_t v={lo,hi};bf16x2_t b=__builtin_convertvector(v,bf16x2_t);return __builtin_bit_cast(unsigned,b);}
#define WAIT_BAR(N) asm volatile("s_waitcnt vmcnt(" #N ") lgkmcnt(0)\n\ts_barrier":::"memory")

__device__ __forceinline__ void qkt(f32x16&p0,f32x16&p1,const char*Kslot,const bf16x8*qr,int r32,int hi){
  const char*kb=Kslot+hi*1024+r32*16;
  #pragma unroll
  for(int d0=0;d0<4;++d0){
    const bf16x8 b0=*reinterpret_cast<const bf16x8*>(kb+d0*2048);
    const bf16x8 b1=*reinterpret_cast<const bf16x8*>(kb+d0*2048+512);
    {p0=__builtin_amdgcn_mfma_f32_32x32x16_bf16(b0,qr[d0],p0,0,0,0);p1=__builtin_amdgcn_mfma_f32_32x32x16_bf16(b1,qr[d0],p1,0,0,0);}}
}
typedef __attribute__((address_space(3))) const char* lds_cptr;
typedef short v4i16_t __attribute__((ext_vector_type(4)));
__device__ __forceinline__ void kload8(bf16x8*kf,lds_cptr kp){
  kf[0]=*(const __attribute__((address_space(3))) bf16x8*)(kp);      kf[1]=*(const __attribute__((address_space(3))) bf16x8*)(kp+512);
  kf[2]=*(const __attribute__((address_space(3))) bf16x8*)(kp+2048); kf[3]=*(const __attribute__((address_space(3))) bf16x8*)(kp+2560);
  kf[4]=*(const __attribute__((address_space(3))) bf16x8*)(kp+4096); kf[5]=*(const __attribute__((address_space(3))) bf16x8*)(kp+4608);
  kf[6]=*(const __attribute__((address_space(3))) bf16x8*)(kp+6144); kf[7]=*(const __attribute__((address_space(3))) bf16x8*)(kp+6656);
}
__device__ __forceinline__ void kload2(bf16x8*kf,lds_cptr kp,int j){ kf[2*j]=*(const __attribute__((address_space(3))) bf16x8*)(kp+j*2048); kf[2*j+1]=*(const __attribute__((address_space(3))) bf16x8*)(kp+j*2048+512); }
__device__ __forceinline__ s16x4 vtr(lds_cptr p){ return __builtin_bit_cast(s16x4,__builtin_amdgcn_ds_read_tr16_b64_v4i16((__attribute__((address_space(3))) v4i16_t*)p)); }
__device__ __forceinline__ float rowmax(const f32x16&p0,const f32x16&p1){
  float a=max3f(p0[0],p0[1],p1[0]),b=max3f(p0[2],p0[3],p1[1]);a=max3f(a,p1[2],p1[3]);
  #pragma unroll
  for(int r=4;r<16;r+=4){a=max3f(a,p0[r],p0[r+1]);b=max3f(b,p0[r+2],p0[r+3]);a=max3f(a,p1[r],p1[r+1]);b=max3f(b,p1[r+2],p1[r+3]);}
  const float m=max2f(a,b);
  auto rr=__builtin_amdgcn_permlane32_swap(__float_as_uint(m),__float_as_uint(m),false,false);
  return max2f(__uint_as_float(rr[0]),__uint_as_float(rr[1]));
}
__device__ __forceinline__ void pv(f32x16*o,int vb,bf16x8 pa0,bf16x8 pa1,bf16x8 pa2,bf16x8 pa3){
  #pragma unroll
  for(int d0=0;d0<2;++d0){s16x4 lo[4],hi[4];
    #pragma unroll
    for(int ks=0;ks<4;++ks){
      asm volatile("ds_read_b64_tr_b16 %0,%1 offset:%c2":"=&v"(lo[ks]):"v"(vb),"i"(d0*4096+ks*1024):"memory");
      asm volatile("ds_read_b64_tr_b16 %0,%1 offset:%c2":"=&v"(hi[ks]):"v"(vb),"i"(d0*4096+ks*1024+512):"memory");}
    asm volatile("s_waitcnt lgkmcnt(0)":::"memory");SBAR();
    #define PK(k) (bf16x8){lo[k][0],lo[k][1],lo[k][2],lo[k][3],hi[k][0],hi[k][1],hi[k][2],hi[k][3]}
    o[d0]=__builtin_amdgcn_mfma_f32_32x32x16_bf16(pa0,PK(0),o[d0],0,0,0);
    o[d0]=__builtin_amdgcn_mfma_f32_32x32x16_bf16(pa1,PK(1),o[d0],0,0,0);
    o[d0]=__builtin_amdgcn_mfma_f32_32x32x16_bf16(pa2,PK(2),o[d0],0,0,0);
    o[d0]=__builtin_amdgcn_mfma_f32_32x32x16_bf16(pa3,PK(3),o[d0],0,0,0);
    #undef PK
  }
}

#ifndef ATTN_STORE16
#define ATTN_STORE16(p,v) (*(u32x4*)(p)=(v))
#endif
template<int THRL> __device__ __forceinline__ void attn_unit(int b,int h,int qb,const bf16*Q,const bf16*__restrict__ K,const bf16*__restrict__ V,bf16*O,char*shm,const float*fxf,float bfh){
  int tid_o=threadIdx.x; asm volatile("":"+v"(tid_o)); const int tid=tid_o,lane=tid&63,r32=lane&31,hi=lane>>5; const int wid=__builtin_amdgcn_readfirstlane(tid>>6);
  const long rowbase=(long)b*SEQ; const int q0=qb*QB;
  const lds_cptr shm3b=(lds_cptr)shm;

  {
    float* bl=(float*)(shm+LDS_BIAS); float* sc=(float*)(shm+LDS_SCAN);
    const int nkeys=q0+QB; const int s0=4*tid; float c0=0.f,c1=0.f,c2=0.f,c3=0.f;
    if(s0<nkeys){ const float* fp=fxf+((long)(rowbase+s0))*8+h; float z0=fp[0]+bfh,z1=fp[8]+bfh,z2=fp[16]+bfh,z3=fp[24]+bfh;
      c0=fminf(z0,0.f)-log1pf(expf(-fabsf(z0))); c1=c0+(fminf(z1,0.f)-log1pf(expf(-fabsf(z1)))); c2=c1+(fminf(z2,0.f)-log1pf(expf(-fabsf(z2)))); c3=c2+(fminf(z3,0.f)-log1pf(expf(-fabsf(z3)))); }
    float incl=c3;
    #pragma unroll
    for(int o=1;o<64;o<<=1){ const float t_=__shfl_up(incl,o); if(lane>=o)incl+=t_; }
    if(lane==63)sc[wid]=incl;
    __syncthreads();
    float woff=0.f;
    #pragma unroll
    for(int w_=0;w_<NW;++w_){ const float t_=sc[w_]; if(w_<wid)woff+=t_; }
    const float excl=woff+incl-c3; c0+=excl;c1+=excl;c2+=excl;c3+=excl;
    if(s0<nkeys){ bl[s0]=c0; bl[s0+1]=c1; bl[s0+2]=c2; bl[s0+3]=c3; }
    __syncthreads();
    const float cref=bl[q0];
    __syncthreads();
    const float L2E=1.4426950408889634f;
    if(s0<nkeys){ bl[s0]=(cref-c0)*L2E; bl[s0+1]=(cref-c1)*L2E; bl[s0+2]=(cref-c2)*L2E; bl[s0+3]=(cref-c3)*L2E; }
    __syncthreads();
  }
  const __attribute__((address_space(3))) float* bias3=(const __attribute__((address_space(3))) float*)(shm3b+LDS_BIAS)+4*hi;
  #define CINIT(P0,P1,t) do{ const __attribute__((address_space(3))) float* bp_=bias3+64*(t); \
    _Pragma("unroll") for(int g_=0;g_<4;++g_){ const f32x4b b0_=*(const __attribute__((address_space(3))) f32x4b*)(bp_+8*g_); const f32x4b b1_=*(const __attribute__((address_space(3))) f32x4b*)(bp_+32+8*g_); \
      P0[4*g_]=b0_[0]-mhat;P0[4*g_+1]=b0_[1]-mhat;P0[4*g_+2]=b0_[2]-mhat;P0[4*g_+3]=b0_[3]-mhat; P1[4*g_]=b1_[0]-mhat;P1[4*g_+1]=b1_[1]-mhat;P1[4*g_+2]=b1_[2]-mhat;P1[4*g_+3]=b1_[3]-mhat; } }while(0)
  const bf16*Qw=Q+(rowbase+q0+wid*QBLK)*DM+h*D;
  const bf16*Kh=K+rowbase*DM+h*D,*Vh=V+rowbase*DM+h*D;
  const unsigned lds0=(unsigned)(uintptr_t)shm;
  float*wsf=(float*)(shm+LDS_WS)+wid*64;
  const bf16*ksrc=Kh+(long)lane*DM+wid*8;
  const bf16*vsrc=Vh+(long)(16*(wid&3)+(lane>>2))*DM+(wid>>2)*32+(lane&3)*8;
  const unsigned kdst=lds0+LDS_K+wid*1024, vdst=lds0+LDS_V+wid*1024;
  #define DMA_K(t,slot) glds16(ksrc+(long)(t)*KVBLK*DM,(unsigned)__builtin_amdgcn_readfirstlane(kdst+(slot)))
  #define DMA_V(t,slot) glds16(vsrc+(long)(t)*KVBLK*DM,(unsigned)__builtin_amdgcn_readfirstlane(vdst+(slot)))
  const int vb0=(int)(lds0+LDS_V)+((lane>>4)&1)*32+(lane&3)*8+(4*hi+((lane&15)>>2))*64;
  const char*Kbase=shm+LDS_K; bf16x8 kf[8];
  const lds_cptr shm3=(lds_cptr)shm; const lds_cptr kp0=shm3+LDS_K+hi*1024+r32*16; const lds_cptr vp0=shm3+LDS_V+((lane>>4)&1)*32+(lane&3)*8+(4*hi+((lane&15)>>2))*64;
  const int NT=(q0+QB)/KVBLK;
  DMA_K(0,0);DMA_V(0,0);DMA_K(1,SLOTB);
  bf16x8 qr[4];
  #pragma unroll
  for(int d0=0;d0<4;++d0)qr[d0]=*reinterpret_cast<const bf16x8*>(&Qw[(long)r32*DM+d0*16+hi*8]);
  float mhat=((const float*)(shm+LDS_BIAS))[q0+wid*QBLK+r32],l_reg=0.f;f32x16 o[2];o[0]=f32x16{};o[1]=f32x16{};
  const int qrel=wid*QBLK+r32;
  #define CMASK(P0,P1,t) do{int jb_=(t)-(NT-4); if(jb_>=0)cmask(P0,P1,jb_,qrel,hi);}while(0)
  bool resc=false;
  #define START(P0,P1) do{ const float rm=rowmax(P0,P1); resc=false; \
    { const float dl=__builtin_fmaxf(rm,0.f); mhat=fadd_s(mhat,dl); \
      _Pragma("unroll") for(int r=0;r<16;++r){P0[r]=fsub_s(P0[r],dl);P1[r]=fsub_s(P1[r],dl);} \
      } \
    _Pragma("unroll") for(int r=0;r<16;++r)P0[r]=__builtin_amdgcn_exp2f(P0[r]); }while(0)
  #define RESC() do{ if(resc){ asm volatile("s_waitcnt lgkmcnt(0)":::"memory"); \
      _Pragma("unroll") for(int d_=0;d_<2;++d_) _Pragma("unroll") for(int r=0;r<16;++r)o[d_][r]*=wsf[crow(r,hi)]; } }while(0)
  f32x16 pA0,pA1,pB0,pB1;
  int sl_prev=0,sl_cur=0,sl_next=SLOTB;
  #define ROT() do{sl_prev=sl_cur;sl_cur=sl_next;sl_next=(sl_next==(NSLOT-1)*SLOTB)?0:sl_next+SLOTB;}while(0)
  DMA_K(2,2*SLOTB);
  WAIT_BAR(3);
  CINIT(pA0,pA1,0); qkt(pA0,pA1,Kbase,qr,r32,hi);asm volatile("s_nop 15\n\ts_nop 7":"+v"(pA0),"+v"(pA1));CMASK(pA0,pA1,0);
  START(pA0,pA1);
  _Pragma("unroll") for(int r=0;r<16;++r)pA1[r]=__builtin_amdgcn_exp2f(pA1[r]);
  WAIT_BAR(0);
  DMA_K(3,0);DMA_V(1,SLOTB);
  ROT();
  kload8(kf,kp0+sl_cur);
  WAIT_BAR(2);
  s16x4 vlo[8],vhi[8]; u32x4 pw0,pw1,pw2,pw3;
  #define PKW(P,B) cvtpk_s(P[B],P[B+1])
  #define PAF(k) __builtin_bit_cast(bf16x8,pw##k)
  #define VFR(i) (bf16x8){vlo[i][0],vlo[i][1],vlo[i][2],vlo[i][3],vhi[i][0],vhi[i][1],vhi[i][2],vhi[i][3]}
  #define PIN(x) asm volatile("":"+v"(x))
  #define MX3(a,b,c) __builtin_fmaxf(__builtin_fmaxf((a),(b)),(c))
  #define GAPA(MF,A0,A1,A2,A3,W0,W1,PW) do{ MF; sacc+=A0; sacc+=A1; sacc+=A2; sacc+=A3; PIN(sacc); W0; W1; PIN(PW); SBAR(); }while(0)
  #define EX(v) __builtin_amdgcn_exp2f(v)
  #define GAPB(MF,X,B) do{ MF; X[B]=EX(X[B]); X[B+1]=EX(X[B+1]); X[B+2]=EX(X[B+2]); X[B+3]=EX(X[B+3]); PIN(X); SBAR(); }while(0)
  #define VRD(i) do{ vlo[i]=vtr(vp_+(((i)>>2)*4096+((i)&3)*1024)); vhi[i]=vtr(vp_+(((i)>>2)*4096+((i)&3)*1024+512)); }while(0)
  #define KRD(G,j) do{ if(G){ kload2(kf,kp0+sl_next,j); SBAR(); } }while(0)
  #define STEP(C0,C1,P0,P1,t,GK,GV,GL) do{ SBAR(); CINIT(C0,C1,t); SBAR(); \
    const lds_cptr vp_=vp0+sl_prev; \
    VRD(0); SBAR(); float sacc=(P0[0]+P0[1]); \
    GAPA(C0=__builtin_amdgcn_mfma_f32_32x32x16_bf16(kf[0],qr[0],C0,0,0,0), P0[2],P0[3],P0[4],P0[5],     pw0[0]=PKW(P0,0), pw0[1]=PKW(P0,2), pw0); \
    VRD(4); SBAR(); GAPA(C1=__builtin_amdgcn_mfma_f32_32x32x16_bf16(kf[1],qr[0],C1,0,0,0), P0[6],P0[7],P0[8],P0[9],     pw0[2]=PKW(P0,4), pw0[3]=PKW(P0,6), pw0); \
    VRD(1); SBAR(); GAPA(C0=__builtin_amdgcn_mfma_f32_32x32x16_bf16(kf[2],qr[1],C0,0,0,0),   P0[10],P0[11],P0[12],P0[13], pw1[0]=PKW(P0,8), pw1[1]=PKW(P0,10), pw1); \
    VRD(5); SBAR(); GAPA(C1=__builtin_amdgcn_mfma_f32_32x32x16_bf16(kf[3],qr[1],C1,0,0,0),   P0[14],P0[15],P1[0],P1[1],   pw1[2]=PKW(P0,12),pw1[3]=PKW(P0,14), pw1); \
    VRD(2); SBAR(); GAPA(C0=__builtin_amdgcn_mfma_f32_32x32x16_bf16(kf[4],qr[2],C0,0,0,0),   P1[2],P1[3],P1[4],P1[5],     pw2[0]=PKW(P1,0), pw2[1]=PKW(P1,2), pw2); \
    VRD(6); SBAR(); GAPA(C1=__builtin_amdgcn_mfma_f32_32x32x16_bf16(kf[5],qr[2],C1,0,0,0),   P1[6],P1[7],P1[8],P1[9],     pw2[2]=PKW(P1,4), pw2[3]=PKW(P1,6), pw2); \
    VRD(3); SBAR(); GAPA(C0=__builtin_amdgcn_mfma_f32_32x32x16_bf16(kf[6],qr[3],C0,0,0,0),   P1[10],P1[11],P1[12],P1[13], pw3[0]=PKW(P1,8), pw3[1]=PKW(P1,10), pw3); \
    VRD(7); SBAR(); GAPA(C1=__builtin_amdgcn_mfma_f32_32x32x16_bf16(kf[7],qr[3],C1,0,0,0),   P1[14],P1[15],0.f,0.f,       pw3[2]=PKW(P1,12),pw3[3]=PKW(P1,14), pw3); \
    l_reg+=sacc; \
    if(GK){DMA_K((t)+3,sl_cur);} if(GV){DMA_V((t)+1,sl_next);} \
    CMASK(C0,C1,t); \
    { float a=MX3(C0[0],C0[1],C1[0]),b=MX3(C0[2],C0[3],C1[1]); a=MX3(a,C1[2],C1[3]); \
      _Pragma("unroll") for(int r=4;r<16;r+=4){a=MX3(a,C0[r],C0[r+1]);b=MX3(b,C0[r+2],C0[r+3]);a=MX3(a,C1[r],C1[r+1]);b=MX3(b,C1[r+2],C1[r+3]);} \
      float rm=__builtin_fmaxf(a,b); { auto rr=__builtin_amdgcn_permlane32_swap(__float_as_uint(rm),__float_as_uint(rm),false,false); rm=__builtin_fmaxf(__uint_as_float(rr[0]),__uint_as_float(rr[1])); } \
      resc=false; \
      if(__builtin_expect(__any(rm>(float)THRL),0)){ const float dl=__builtin_fmaxf(rm,0.f); mhat+=dl; \
        _Pragma("unroll") for(int r=0;r<16;++r){C0[r]-=dl;C1[r]-=dl;} \
        const float f=__builtin_amdgcn_exp2f(-dl); l_reg*=f; if(hi==0)wsf[r32]=f; resc=true; } } \
    SBAR(); \
    GAPB(o[0]=__builtin_amdgcn_mfma_f32_32x32x16_bf16(PAF(0),VFR(0),o[0],0,0,0), C0,0); \
    GAPB(o[1]=__builtin_amdgcn_mfma_f32_32x32x16_bf16(PAF(0),VFR(4),o[1],0,0,0), C0,4); \
    KRD(GL,0); GAPB(o[0]=__builtin_amdgcn_mfma_f32_32x32x16_bf16(PAF(1),VFR(1),o[0],0,0,0), C0,8); \
    KRD(GL,1); GAPB(o[1]=__builtin_amdgcn_mfma_f32_32x32x16_bf16(PAF(1),VFR(5),o[1],0,0,0), C0,12); \
    KRD(GL,2); GAPB(o[0]=__builtin_amdgcn_mfma_f32_32x32x16_bf16(PAF(2),VFR(2),o[0],0,0,0), C1,0); \
    KRD(GL,3); GAPB(o[1]=__builtin_amdgcn_mfma_f32_32x32x16_bf16(PAF(2),VFR(6),o[1],0,0,0), C1,4); \
    GAPB(o[0]=__builtin_amdgcn_mfma_f32_32x32x16_bf16(PAF(3),VFR(3),o[0],0,0,0), C1,8); \
    GAPB(o[1]=__builtin_amdgcn_mfma_f32_32x32x16_bf16(PAF(3),VFR(7),o[1],0,0,0), C1,12); \
    }while(0)
  int t=1;
  #undef CMASK
  #define CMASK(P0,P1,t) do{}while(0)
  for(;t+5<NT;t+=2){
    STEP(pB0,pB1,pA0,pA1,t,true,true,true);     WAIT_BAR(2); RESC(); ROT();
    STEP(pA0,pA1,pB0,pB1,t+1,true,true,true);   WAIT_BAR(2); RESC(); ROT();
  }
  #undef CMASK
  #define CMASK(P0,P1,t) do{int jb_=(t)-(NT-4); if(jb_>=0)cmask(P0,P1,jb_,qrel,hi);}while(0)
  #define ENDW(tt) do{ if((tt)+3<NT){WAIT_BAR(2);} else if((tt)+2<NT){WAIT_BAR(1);} else {WAIT_BAR(0);} }while(0)
  for(;t+1<NT;t+=2){
    STEP(pB0,pB1,pA0,pA1,t,(t+3<NT),(t+1<NT),(t+1<NT));       ENDW(t);   RESC(); ROT();
    STEP(pA0,pA1,pB0,pB1,t+1,(t+4<NT),(t+2<NT),(t+2<NT));     ENDW(t+1); RESC(); ROT();
  }
  STEP(pB0,pB1,pA0,pA1,NT-1,false,false,false); RESC();
  { float sacc=pB0[0]+pB0[1]; _Pragma("unroll") for(int r=2;r<16;++r)sacc+=pB0[r]; _Pragma("unroll") for(int r=0;r<16;++r)sacc+=pB1[r]; l_reg+=sacc;
    pw0=(u32x4){PKW(pB0,0),PKW(pB0,2),PKW(pB0,4),PKW(pB0,6)};pw1=(u32x4){PKW(pB0,8),PKW(pB0,10),PKW(pB0,12),PKW(pB0,14)};pw2=(u32x4){PKW(pB1,0),PKW(pB1,2),PKW(pB1,4),PKW(pB1,6)};pw3=(u32x4){PKW(pB1,8),PKW(pB1,10),PKW(pB1,12),PKW(pB1,14)};
    SBAR(); pv(o,vb0+sl_cur,PAF(0),PAF(1),PAF(2),PAF(3)); }
  #undef PKW
  #undef PAF
  #undef VFR
  #undef PIN
  #undef MX3
  #undef GAPA
  #undef GAPB
  #undef EX
  #undef VRD
  #undef KRD
  #undef STEP
  #undef ENDW
  {auto rr=__builtin_amdgcn_permlane32_swap(__float_as_uint(l_reg),__float_as_uint(l_reg),false,false);l_reg=__uint_as_float(rr[0])+__uint_as_float(rr[1]);}
  if(hi==0)wsf[32+r32]=l_reg;asm volatile("s_waitcnt lgkmcnt(0)":::"memory");
  float rli[16];
  #pragma unroll
  for(int r=0;r<16;++r)rli[r]=__builtin_amdgcn_rcpf(wsf[32+crow(r,hi)]);
  bf16*Ow=O+(rowbase+q0+wid*QBLK)*DM+h*D;
  { bf16*stg=(bf16*)(shm+LDS_OST)+wid*2048;
    #pragma unroll
    for(int r=0;r<16;++r){const int orow=crow(r,hi);
      #pragma unroll
      for(int d0=0;d0<2;++d0)stg[orow*64+d0*32+r32]=__float2bfloat16(o[d0][r]*rli[r]);}
    asm volatile("s_waitcnt lgkmcnt(0)":::"memory");
    #pragma unroll
    for(int i=0;i<4;++i){const int row=i*8+(lane>>3),ch=lane&7; const u32x4 v=*(const u32x4*)(stg+row*64+ch*8); ATTN_STORE16(Ow+(long)row*DM+ch*8,v);} }
  asm volatile("s_waitcnt lgkmcnt(0)\n\ts_barrier":::"memory");
  #undef CINIT
  #undef DMA_K
  #undef DMA_V
  #undef CMASK
  #undef START
  #undef RESC
  #undef ROT
}
constexpr int ATTN_LDS_BYTES=LDS_BYTES;
struct AttnTensors { const bf16* Q; const bf16* K; const bf16* V; bf16* O; const float* fxf; const float* bf; };
struct AttnUnit { int bh; int qb; };
struct StaticOrder {
  int vcu;
  __device__ __forceinline__ explicit StaticOrder(int grid,int block):vcu((grid%8==0)?((block%8)*(grid/8)+block/8):block){}
  __device__ __forceinline__ bool next(int i,AttnUnit&u)const{ const int idx=vcu+ (i>>1)*0; if(i>=2||idx>=256)return false; const int s=idx&3; u.bh=idx>>2; u.qb=(i==0)?s:7-s; return true; }
  __device__ __forceinline__ void a_ready(const AttnUnit&)const{}
  __device__ __forceinline__ void done(const AttnUnit&)const{}
};
template<class Sched,int THRL=8> __device__ __forceinline__ void attn_phase(char*lds,const AttnTensors&T,const Sched&S){
  AttnUnit u;
  for(int i=0;S.next(i,u);++i){ S.a_ready(u); attn_unit<THRL>(u.bh/NHEAD,u.bh%NHEAD,u.qb,T.Q,T.K,T.V,T.O,lds,T.fxf,T.bf[u.bh%NHEAD]); S.done(u); }
}
#undef SBAR
#undef WAIT_BAR
}

constexpr int M = 16384, DMOD = 1024, SEQL = 2048, FFN_H = 2816, INTOT = 7176;
constexpr size_t MiB = 1u << 20;
constexpr size_t WS_HB = 0, WS_HBL = 32 * MiB, WS_YA = 64 * MiB, WS_YB = 80 * MiB, WS_YC = 96 * MiB;
constexpr size_t WS_FK = WS_YA, WS_FQ = WS_YB, WS_FV = WS_YC;
constexpr size_t WS_ZQ = 112 * MiB, WS_ZF = 128 * MiB, WS_ZI = 160 * MiB, WS_ZG = 176 * MiB, WS_SU = 192 * MiB, WS_KV = 208 * MiB, WS_SE = 240 * MiB, WS_MISC = 248 * MiB;
constexpr size_t WS_GATES = 112 * MiB, WS_MERGED = 208 * MiB, WS_PRE = 112 * MiB, WS_H1B = 176 * MiB, WS_FFH = 0;
constexpr size_t MISC_FXF = 0, MISC_DEC = 1 * MiB, MISC_LB = 2 * MiB;
constexpr size_t DO_WIN = 0, DO_WGLU = 14 * MiB, DO_WBR = 14 * MiB + MiB / 2, DO_WOUT = 17 * MiB + MiB / 2, DO_WGU = 19 * MiB + MiB / 2, DO_WDN = 30 * MiB + MiB / 2,
                 DO_TM = 36 * MiB, DO_EM = 42 * MiB, DO_LAM = 44 * MiB, DO_YG = 48 * MiB;
constexpr int LDS_BYTES = 147456;
constexpr float DN_ALPHA = 1.4142135623730951f, LN_EPS = 1e-5f, RMS_EPS = 1e-6f;

typedef unsigned short u16;
typedef unsigned v4u __attribute__((ext_vector_type(4)));
typedef unsigned v2u __attribute__((ext_vector_type(2)));
typedef float f32x4 __attribute__((ext_vector_type(4)));
typedef short bf16x8 __attribute__((ext_vector_type(8)));
__device__ __forceinline__ unsigned f2bf(float f) { unsigned u = __builtin_bit_cast(unsigned, f); return (u + 0x7fffu + ((u >> 16) & 1u)) >> 16; }
__device__ __forceinline__ unsigned pk2(float lo, float hi) { return f2bf(lo) | (f2bf(hi) << 16); }
__device__ __forceinline__ float bf2f(unsigned h) { return __builtin_bit_cast(float, h << 16); }
__device__ __forceinline__ float bflo(unsigned w) { return __builtin_bit_cast(float, w << 16); }
__device__ __forceinline__ float bfhi(unsigned w) { return __builtin_bit_cast(float, w & 0xffff0000u); }
__device__ __forceinline__ float sigm(float x) { return 1.f / (1.f + __expf(-x)); }
__device__ __forceinline__ float wave_sum(float v) {
#pragma unroll
    for (int o = 1; o < 64; o <<= 1) v += __shfl_xor(v, o);
    return v;
}

struct Args { const float* in[25]; float* out; unsigned char* ws; };

namespace pg8 {
struct EpiIn {
    static constexpr bool PERM = true, AFTER_DRAIN = false, KEEP_ACC = false;
    unsigned char* ws; const float* lb; float c2;
    __device__ __forceinline__ void operator()(f32x4 (&acc)[2][2][4][2], const Unit& u, int wr, int wc, int fr, int fq) const {
        const int seg = u.pn >> 1;
        const int cbase = (u.pn & 1) * 256 + wc * 32 + 8 * fq;
        const int row0 = (u.pm * BM) + wr * 64 + fr;
#pragma unroll
        for (int ai = 0; ai < 2; ++ai)
#pragma unroll
            for (int m = 0; m < 4; ++m) {
                const int row = row0 + ai * HALF + m * 16;
#pragma unroll
                for (int bj = 0; bj < 2; ++bj) {
                    const int c = cbase + bj * HALF;
                    f32x4 v0 = acc[ai][bj][m][0], v1 = acc[ai][bj][m][1];
                    if (seg == 1) {
                        const f32x4 l0 = *(const f32x4*)(lb + c), l1 = *(const f32x4*)(lb + c + 4);
#pragma unroll
                        for (int e = 0; e < 4; ++e) { v0[e] = __logf(l0[e] + (1.f - l0[e]) * sigm(v0[e])); v1[e] = __logf(l1[e] + (1.f - l1[e]) * sigm(v1[e])); }
                        float* p = (float*)(ws + WS_ZF) + (size_t)row * 512 + c;
                        *(f32x4*)p = v0; *(f32x4*)(p + 4) = v1;
                    } else {
                        if (seg == 4) { v0 = v0 * c2; v1 = v1 * c2; }
                        u32x4 w; w.x = cvt_pk_bf16(v0[0], v0[1]); w.y = cvt_pk_bf16(v0[2], v0[3]); w.z = cvt_pk_bf16(v1[0], v1[1]); w.w = cvt_pk_bf16(v1[2], v1[3]);
                        size_t off;
                        if (seg == 7) off = WS_SU + 2 * (((size_t)((c >> 4) * 1024 + (row >> 4))) * 256 + (size_t)((row & 15) * 16 + (c & 15)));
                        else {
                            const size_t base = seg == 0 ? WS_ZQ : seg == 2 ? WS_ZI : seg == 3 ? WS_ZG : seg == 4 ? WS_FQ : seg == 5 ? WS_FK : WS_FV;
                            off = base + 2 * ((size_t)row * 512 + c);
                        }
                        *(u32x4*)(ws + off) = w;
                    }
                }
            }
    }
};
struct EpiGate {
    static constexpr bool PERM = true, AFTER_DRAIN = false, KEEP_ACC = false;
    bf16_t* G;
    __device__ __forceinline__ void operator()(f32x4 (&acc)[2][2][4][2], const Unit& u, int wr, int wc, int fr, int fq) const {
        const int col0 = u.pn * BM + wc * 32 + 8 * fq, row0 = u.pm * BM + wr * 64 + fr;
#pragma unroll
        for (int ai = 0; ai < 2; ++ai)
#pragma unroll
            for (int m = 0; m < 4; ++m) { bf16_t* rowp = G + (size_t)(row0 + ai * HALF + m * 16) * 3072 + col0;
#pragma unroll
                for (int bj = 0; bj < 2; ++bj) { const f32x4 v0 = acc[ai][bj][m][0], v1 = acc[ai][bj][m][1];
                    u32x4 w; w.x = cvt_pk_bf16(sigm(v0[0]), sigm(v0[1])); w.y = cvt_pk_bf16(sigm(v0[2]), sigm(v0[3])); w.z = cvt_pk_bf16(sigm(v1[0]), sigm(v1[1])); w.w = cvt_pk_bf16(sigm(v1[2]), sigm(v1[3]));
                    *(u32x4*)(rowp + bj * HALF) = w; } }
    }
};
struct EpiGlu {
    static constexpr bool PERM = true, AFTER_DRAIN = false, KEEP_ACC = false;
    const bf16_t* Y; bf16_t* O;
    __device__ __forceinline__ void operator()(f32x4 (&acc)[2][2][4][2], const Unit& u, int wr, int wc, int fr, int fq) const {
        const int col0 = u.pn * BM + wc * 32 + 8 * fq, row0 = u.pm * BM + wr * 64 + fr;
#pragma unroll
        for (int ai = 0; ai < 2; ++ai)
#pragma unroll
            for (int m = 0; m < 4; ++m) { const size_t ro = (size_t)(row0 + ai * HALF + m * 16) * 512 + col0;
#pragma unroll
                for (int bj = 0; bj < 2; ++bj) { const f32x4 v0 = acc[ai][bj][m][0], v1 = acc[ai][bj][m][1];
                    const u32x4 y = *(const u32x4*)(Y + ro + bj * HALF);
                    u32x4 w; w.x = cvt_pk_bf16(bflo(y.x) * sigm(v0[0]), bfhi(y.x) * sigm(v0[1])); w.y = cvt_pk_bf16(bflo(y.y) * sigm(v0[2]), bfhi(y.y) * sigm(v0[3]));
                    w.z = cvt_pk_bf16(bflo(y.z) * sigm(v1[0]), bfhi(y.z) * sigm(v1[1])); w.w = cvt_pk_bf16(bflo(y.w) * sigm(v1[2]), bfhi(y.w) * sigm(v1[3]));
                    *(u32x4*)(O + ro + bj * HALF) = w; } }
    }
};
struct EpiBranch {
    static constexpr bool PERM = true, AFTER_DRAIN = false, KEEP_ACC = true;
    const bf16_t* G; bf16_t* O;
    __device__ __forceinline__ void operator()(f32x4 (&acc)[2][2][4][2], const Unit& u, int wr, int wc, int fr, int fq) const {
        const int br = u.pm >> 6, tm = u.pm & 63, tn = u.pn & 3;
        const int col0 = tn * BM + wc * 32 + 8 * fq, row0 = tm * BM + wr * 64 + fr;
#pragma unroll
        for (int ai = 0; ai < 2; ++ai)
#pragma unroll
            for (int m = 0; m < 4; ++m) { const size_t row = (size_t)(row0 + ai * HALF + m * 16);
#pragma unroll
                for (int bj = 0; bj < 2; ++bj) { f32x4 v0 = acc[ai][bj][m][0], v1 = acc[ai][bj][m][1];
                    const bf16_t* gp = G + row * 3072 + col0 + bj * HALF;
                    if (br < 2) {
                        const u32x4 ga = *(const u32x4*)(gp + br * 1024), gb = *(const u32x4*)(gp + (br + 1) * 1024);
                        v0[0] *= bflo(ga.x) * __builtin_amdgcn_rcpf(bflo(gb.x)); v0[1] *= bfhi(ga.x) * __builtin_amdgcn_rcpf(bfhi(gb.x));
                        v0[2] *= bflo(ga.y) * __builtin_amdgcn_rcpf(bflo(gb.y)); v0[3] *= bfhi(ga.y) * __builtin_amdgcn_rcpf(bfhi(gb.y));
                        v1[0] *= bflo(ga.z) * __builtin_amdgcn_rcpf(bflo(gb.z)); v1[1] *= bfhi(ga.z) * __builtin_amdgcn_rcpf(bfhi(gb.z));
                        v1[2] *= bflo(ga.w) * __builtin_amdgcn_rcpf(bflo(gb.w)); v1[3] *= bfhi(ga.w) * __builtin_amdgcn_rcpf(bfhi(gb.w));
                        acc[ai][bj][m][0] = v0; acc[ai][bj][m][1] = v1;
                    } else {
                        const u32x4 ga = *(const u32x4*)(gp + 2048);
                        u32x4 w; w.x = cvt_pk_bf16(v0[0] * bflo(ga.x), v0[1] * bfhi(ga.x)); w.y = cvt_pk_bf16(v0[2] * bflo(ga.y), v0[3] * bfhi(ga.y));
                        w.z = cvt_pk_bf16(v1[0] * bflo(ga.z), v1[1] * bfhi(ga.z)); w.w = cvt_pk_bf16(v1[2] * bflo(ga.w), v1[3] * bfhi(ga.w));
                        *(u32x4*)(O + row * 1024 + col0 + bj * HALF) = w;
                        acc[ai][bj][m][0] = (f32x4){0.f, 0.f, 0.f, 0.f}; acc[ai][bj][m][1] = (f32x4){0.f, 0.f, 0.f, 0.f};
                    } } }
    }
};
struct BranchOrder {
    StaticOrder so;
    __host__ __device__ void init(int G_, int c_) { so.init(16384, 1024, G_, c_); }
    __host__ __device__ bool next(int i, Unit& u) const { const int r = i / 3, br = i - 3 * r; Unit t; if (!so.next(r, t)) return false; u.pm = t.pm + 64 * br; u.pn = t.pn + 4 * br; return true; }
    __device__ __forceinline__ void a_ready(const Unit&) const {}
    __device__ __forceinline__ void done(const Unit&) const {}
};
struct EpiRes {
    static constexpr bool PERM = false, AFTER_DRAIN = false, KEEP_ACC = false;
    const float* resf; const bf16_t* rhi; const bf16_t* rlo; float* out;
    __device__ __forceinline__ void operator()(f32x4 (&acc)[2][2][4][2], const Unit& u, int wr, int wc, int fr, int fq) const {
        const int col0 = u.pn * BM + wc * 32 + 4 * fq, row0 = u.pm * BM + wr * 64 + fr;
#pragma unroll
        for (int ai = 0; ai < 2; ++ai)
#pragma unroll
            for (int m = 0; m < 4; ++m) { const size_t ro = (size_t)(row0 + ai * HALF + m * 16) * 1024 + col0;
#pragma unroll
                for (int bj = 0; bj < 2; ++bj)
#pragma unroll
                    for (int n = 0; n < 2; ++n) { const size_t o = ro + bj * HALF + n * 16; f32x4 r;
                        if (resf) r = *(const f32x4*)(resf + o);
                        else { const v2u h = *(const v2u*)(rhi + o), l = *(const v2u*)(rlo + o); r[0] = bflo(h.x) + bflo(l.x); r[1] = bfhi(h.x) + bfhi(l.x); r[2] = bflo(h.y) + bflo(l.y); r[3] = bfhi(h.y) + bfhi(l.y); }
                        *(f32x4*)(out + o) = r * 1.4142135623730951f + acc[ai][bj][m][n]; } }
    }
};
struct EpiSwiglu {
    static constexpr bool PERM = true, AFTER_DRAIN = false, KEEP_ACC = false;
    bf16_t* O;
    __device__ __forceinline__ void operator()(f32x4 (&acc)[2][2][4][2], const Unit& u, int wr, int wc, int fr, int fq) const {
        const int col0 = u.pn * 128 + wc * 32 + 8 * fq, row0 = u.pm * BM + wr * 64 + fr;
#pragma unroll
        for (int ai = 0; ai < 2; ++ai)
#pragma unroll
            for (int m = 0; m < 4; ++m) { const f32x4 g0 = acc[ai][0][m][0], g1 = acc[ai][0][m][1], u0 = acc[ai][1][m][0], u1 = acc[ai][1][m][1];
                u32x4 w; w.x = cvt_pk_bf16(g0[0] * sigm(g0[0]) * u0[0], g0[1] * sigm(g0[1]) * u0[1]); w.y = cvt_pk_bf16(g0[2] * sigm(g0[2]) * u0[2], g0[3] * sigm(g0[3]) * u0[3]);
                w.z = cvt_pk_bf16(g1[0] * sigm(g1[0]) * u1[0], g1[1] * sigm(g1[1]) * u1[1]); w.w = cvt_pk_bf16(g1[2] * sigm(g1[2]) * u1[2], g1[3] * sigm(g1[3]) * u1[3]);
                *(u32x4*)(O + (size_t)(row0 + ai * HALF + m * 16) * 2816 + col0) = w; }
    }
};
}
#define GAS __attribute__((address_space(1)))
#define LAS __attribute__((address_space(3)))
typedef unsigned short bf16;
typedef unsigned v4u __attribute__((ext_vector_type(4)));
typedef float f32x4 __attribute__((ext_vector_type(4)));
typedef short bf16x8 __attribute__((ext_vector_type(8)));
typedef GAS unsigned gu32;
typedef GAS unsigned long long gu64;
#define RLX_AGENT __ATOMIC_RELAXED, __HIP_MEMORY_SCOPE_AGENT
#define LDS_WAIT() asm volatile("s_waitcnt lgkmcnt(0)" ::: "memory")
#define VM_WAIT() asm volatile("s_waitcnt vmcnt(0)" ::: "memory")
__device__ __forceinline__ unsigned long long rt() { return __builtin_amdgcn_s_memrealtime(); }
#define XB_TMO      128
#define XB_XCNT(j)  (256  + 64 * (j))
#define XB_XSUB(j)  (1280 + 64 * (j))
#define XB_XGEN(j)  (2304 + 64 * (j))
#define XB_TOP      3328
#define XB_TOPGEN   3392
#define XCD_BAR_WORDS 3456
#define XB_SPIN_CAP (1u << 18)

__device__ __forceinline__ unsigned xb_ld(unsigned* p)              { return __hip_atomic_load(p, __ATOMIC_RELAXED, __HIP_MEMORY_SCOPE_AGENT); }
__device__ __forceinline__ unsigned xb_add(unsigned* p, unsigned v) { return __hip_atomic_fetch_add(p, v, __ATOMIC_RELAXED, __HIP_MEMORY_SCOPE_AGENT); }
__device__ __forceinline__ unsigned xb_xcc_id() { return (unsigned)__builtin_amdgcn_s_getreg((3 << 11) | 20) & 0xFu; }
#define XB_SPIN(cond, bar) do { unsigned _sp = 0; while (cond) { __builtin_amdgcn_s_sleep(1); \
    if ((++_sp & 255u) == 0u) { if (xb_ld(&(bar)[XB_TMO])) break; if (_sp > XB_SPIN_CAP) { atomicAdd(&(bar)[XB_TMO], 1u); break; } } } } while (0)

struct XcdBarrier {
    unsigned* bar; unsigned x;
    volatile LAS unsigned* st;
};

__device__ __forceinline__ XcdBarrier xcd_barrier_post(unsigned* bar, volatile LAS unsigned* st) {
    XcdBarrier b; b.bar = bar; b.x = xb_xcc_id(); b.st = st;
    if (threadIdx.x == 0) (void)xb_add(&bar[XB_XCNT(b.x)], 1u);
    return b;
}
__device__ __forceinline__ void xcd_barrier_complete(unsigned* bar, unsigned x, unsigned& nloc, unsigned& nx) {
    const unsigned G = gridDim.x * gridDim.y * gridDim.z;
    unsigned sum, cnt, mine, sp = 0u;
    for (;;) {
        sum = 0u; cnt = 0u; mine = 0u;
#pragma unroll
        for (unsigned j = 0; j < 16; ++j) { const unsigned c = xb_ld(&bar[XB_XCNT(j)]); sum += c; cnt += (c > 0u) ? 1u : 0u; mine = (j == x) ? c : mine; }
        if (sum == G) break;
        __builtin_amdgcn_s_sleep(1);
        if ((++sp & 255u) == 0u) { if (xb_ld(&bar[XB_TMO])) break; if (sp > XB_SPIN_CAP) { atomicAdd(&bar[XB_TMO], 1u); break; } }
    }
    nloc = mine > 0u ? mine : 1u; nx = cnt > 0u ? cnt : 1u;
}

__device__ __forceinline__ void xcd_barrier(const XcdBarrier& b) {
    asm volatile("s_waitcnt vmcnt(0)" ::: "memory");
    __syncthreads();
    if (threadIdx.x == 0) {
        unsigned* bar = b.bar;
        __builtin_amdgcn_s_waitcnt(0);
        unsigned nloc = b.st[0], nx = b.st[1];
        if (nloc == 0u) { xcd_barrier_complete(bar, b.x, nloc, nx); b.st[0] = nloc; b.st[1] = nx; }
        const unsigned old = xb_add(&bar[XB_XSUB(b.x)], 1u);
        const unsigned gen = old / nloc;
        if (old + 1u == (gen + 1u) * nloc) {
            __builtin_amdgcn_fence(__ATOMIC_RELEASE, "agent");
            asm volatile("s_waitcnt vmcnt(0)" ::: "memory");
            const unsigned og = xb_add(&bar[XB_TOP], 1u);
            const unsigned tg = og / nx;
            if (og + 1u == (tg + 1u) * nx) xb_add(&bar[XB_TOPGEN], 1u);
            else XB_SPIN(xb_ld(&bar[XB_TOPGEN]) == tg, bar);
            __builtin_amdgcn_fence(__ATOMIC_ACQUIRE, "agent");
            xb_add(&bar[XB_XGEN(b.x)], 1u);
            asm volatile("s_waitcnt vmcnt(0)" ::: "memory");
        } else {
            XB_SPIN(xb_ld(&bar[XB_XGEN(b.x)]) == gen, bar);
            __builtin_amdgcn_fence(__ATOMIC_ACQUIRE, "agent");
            asm volatile("s_waitcnt vmcnt(0)" ::: "memory");
        }
    }
    __syncthreads();
}

struct Frame { unsigned char* lds; unsigned char* ws; unsigned char* dout; int G, vcu; };
__device__ __forceinline__ int opq_tid() { int t = threadIdx.x; asm volatile("" : "+v"(t)); return t; }
#define F_TID (opq_tid())
#define F_LANE (opq_tid() & 63)
#define F_WAVE (__builtin_amdgcn_readfirstlane(opq_tid() >> 6))

struct CvtP { const float* src; u16* dst; int ld, K, ncb, grp, stride, base, r; };
__device__ __forceinline__ CvtP cvt_job(const Args& a, int l, unsigned char* d, int it) {
    constexpr int BIG = 1 << 30;
    constexpr int I0 = 16 * 112, I1 = 16 * 16, I2 = 16 * 96, I3 = 8 * 16, I4 = 8 * 32, I7 = 16 * 32, I8 = 16 * 88;
    const float* win = a.in[1] + (size_t)l * DMOD * INTOT;
    int r = it;
    if (r < I0) return CvtP{win, (u16*)(d + DO_WIN), INTOT, 1024, 112, BIG, 0, 0, r}; r -= I0;
    if (r < I1) return CvtP{win + 3592, (u16*)(d + DO_WIN), INTOT, 1024, 16, BIG, 0, 3584, r}; r -= I1;
    if (r < I2) return CvtP{win + 4104, (u16*)(d + DO_WIN), INTOT, 1024, 96, BIG, 0, 4096, r}; r -= I2;
    if (r < I3) return CvtP{a.in[13] + (size_t)l * 512 * 512, (u16*)(d + DO_WGLU), 512, 512, 16, BIG, 0, 0, r}; r -= I3;
    if (r < I4) return CvtP{a.in[14] + (size_t)l * 512 * 1024, (u16*)(d + DO_WBR), 1024, 512, 32, BIG, 0, 0, r}; r -= I4;
    if (r < I4) return CvtP{a.in[15] + (size_t)l * 512 * 1024, (u16*)(d + DO_WBR), 1024, 512, 32, BIG, 0, 1024, r}; r -= I4;
    if (r < I4) return CvtP{a.in[16] + (size_t)l * 512 * 1024, (u16*)(d + DO_WBR), 1024, 512, 32, BIG, 0, 2048, r}; r -= I4;
    if (r < I7) return CvtP{a.in[17] + (size_t)l * 1024 * 1024, (u16*)(d + DO_WOUT), 1024, 1024, 32, BIG, 0, 0, r}; r -= I7;
    if (r < I8) return CvtP{a.in[20] + (size_t)l * 1024 * FFN_H, (u16*)(d + DO_WGU), FFN_H, 1024, 88, 128, 256, 0, r}; r -= I8;
    if (r < I8) return CvtP{a.in[21] + (size_t)l * 1024 * FFN_H, (u16*)(d + DO_WGU), FFN_H, 1024, 88, 128, 256, 128, r}; r -= I8;
    return CvtP{a.in[22] + (size_t)l * FFN_H * 1024, (u16*)(d + DO_WDN), 1024, FFN_H, 32, BIG, 0, 0, r};
}
__device__ __forceinline__ void cvt_load(const CvtP& p, int lane, float (&v)[32]) {
    const int kb = p.r / p.ncb, nb = p.r - kb * p.ncb, k0 = 64 * kb, n0 = 32 * nb;
    const float* s = p.src + (size_t)(k0 + (lane >> 5)) * p.ld + n0 + (lane & 31);
#pragma unroll
    for (int i = 0; i < 32; ++i) v[i] = s[(size_t)(2 * i) * p.ld];
}
__device__ __forceinline__ void cvt_store(const CvtP& p, int lane, const float (&v)[32], float* scr) {
    const int kb = p.r / p.ncb, nb = p.r - kb * p.ncb, k0 = 64 * kb, n0 = 32 * nb;
#pragma unroll
    for (int i = 0; i < 32; ++i) scr[(2 * i + (lane >> 5)) * 33 + (lane & 31)] = v[i];
    asm volatile("s_waitcnt lgkmcnt(0)" ::: "memory");
    const int c = lane & 7;
    const int drow0 = p.base + (n0 / p.grp) * p.stride + (n0 % p.grp);
#pragma unroll
    for (int j = 0; j < 4; ++j) { const int n = (lane >> 3) + 8 * j; const float* s = scr + (8 * c) * 33 + n;
        v4u o; o.x = pk2(s[0 * 33], s[1 * 33]); o.y = pk2(s[2 * 33], s[3 * 33]); o.z = pk2(s[4 * 33], s[5 * 33]); o.w = pk2(s[6 * 33], s[7 * 33]);
        *(v4u*)(p.dst + (size_t)(drow0 + n) * p.K + k0 + 8 * c) = o; }
    asm volatile("s_waitcnt lgkmcnt(0)" ::: "memory");
}
__device__ __forceinline__ void convert_weights(const Frame& F, const Args& a, int l) {
    const int lane = F_LANE, wave = F_WAVE;
    float* scr = (float*)(F.lds + wave * 16384);
    const int gw = F.vcu * 8 + wave, NGW = F.G * 8;
    constexpr int NIT = 16 * 112 + 16 * 16 + 16 * 96 + 8 * 16 + 3 * 8 * 32 + 16 * 32 + 2 * 16 * 88 + 44 * 32;
    float v0[32], v1[32];
    int it = gw;
    CvtP p0 = cvt_job(a, l, F.dout, it < NIT ? it : 0), p1 = p0;
    if (it < NIT) cvt_load(p0, lane, v0);
    while (it < NIT) {
        const int it1 = it + NGW, it2 = it + 2 * NGW;
        if (it1 < NIT) { p1 = cvt_job(a, l, F.dout, it1); cvt_load(p1, lane, v1); }
        cvt_store(p0, lane, v0, scr);
        if (it1 >= NIT) break;
        if (it2 < NIT) { p0 = cvt_job(a, l, F.dout, it2); cvt_load(p0, lane, v0); }
        cvt_store(p1, lane, v1, scr);
        it = it2;
    }
}

__device__ __forceinline__ void s5_mats(const Frame& F, const Args& a, int l) {
    float2* LP = (float2*)(F.lds);
    float2* BB = (float2*)(F.lds + 16384);
    float2* CC = (float2*)(F.lds + 32768);
    float* KT = (float*)(F.lds + 49152);
    u16* TM = (u16*)(F.dout + DO_TM); u16* EM = (u16*)(F.dout + DO_EM); float2* LAM = (float2*)(F.dout + DO_LAM);
    const int tid = F_TID;
    for (int unit = blockIdx.x; unit < 256; unit += F.G) {
        const int g = unit >> 3, part = unit & 7;
        __syncthreads();
        const float dt = __expf(a.in[7][l * 32 + g]);
        const float* lre = a.in[5] + (size_t)(l * 32 + g) * 64; const float* lim = a.in[6] + (size_t)(l * 32 + g) * 64;
        for (int e = tid; e < 17 * 64; e += 512) { const int tau = e >> 6, p = e & 63; const float mg = expf(lre[p] * dt * (float)tau); float sn, cs; sincosf(lim[p] * dt * (float)tau, &sn, &cs); LP[e] = make_float2(mg * cs, mg * sn); }
        for (int e = tid; e < 1024; e += 512) { const int p = e >> 4;
            const float lr = lre[p], li = lim[p]; const float mg = expf(lr * dt); float sn, cs; sincosf(li * dt, &sn, &cs);
            const float nr = mg * cs - 1.f, ni = mg * sn, den = 1.f / (lr * lr + li * li);
            const float qr = (nr * lr + ni * li) * den, qi = (ni * lr - nr * li) * den;
            const size_t bi = ((size_t)(l * 32 + g) * 64 + p) * 16 + (e & 15);
            const float br = a.in[8][bi], bim = a.in[9][bi];
            BB[e] = make_float2(qr * br - qi * bim, qr * bim + qi * br);
            const size_t ci = (size_t)(l * 32 + g) * 1024 + e;
            CC[e] = make_float2(a.in[10][ci], a.in[11][ci]); }
        __syncthreads();
        for (int e = tid; e < 4096; e += 512) { const int tau = e >> 8, hp = (e >> 4) & 15, h = e & 15; float s = 0.f;
            for (int p = 0; p < 64; ++p) { const float2 c = CC[hp * 64 + p], w = LP[tau * 64 + p], b = BB[p * 16 + h];
                const float wr_ = c.x * w.x - c.y * w.y, wi_ = c.x * w.y + c.y * w.x; s += wr_ * b.x - wi_ * b.y; }
            if (tau == 0 && hp == h) s += a.in[12][(size_t)(l * 32 + g) * 16 + h];
            KT[e] = s; }
        __syncthreads();
        for (int e = tid; e < 32 * 384; e += 512) { const int rr = e / 384, col = e - rr * 384; const int i = 2 * part + (rr >> 4), hp = rr & 15; float v;
            if (col < 256) { const int j = col >> 4, h = col & 15; v = (j <= i) ? KT[((i - j) * 16 + hp) * 16 + h] : 0.f; }
            else { const int p = (col - 256) & 63; const float2 c = CC[hp * 64 + p], w = LP[(i + 1) * 64 + p]; v = (col < 320) ? (c.x * w.x - c.y * w.y) : -(c.x * w.y + c.y * w.x); }
            TM[((size_t)g * 256 + i * 16 + hp) * 384 + col] = (u16)f2bf(v); }
        for (int e = tid; e < 16 * 256; e += 512) { const int r = 16 * part + (e >> 8), col = e & 255, j = col >> 4, h = col & 15, p = r & 63;
            const float2 w = LP[(15 - j) * 64 + p], b = BB[p * 16 + h];
            const float v = (r < 64) ? (w.x * b.x - w.y * b.y) : (w.x * b.y + w.y * b.x);
            EM[((size_t)g * 128 + r) * 256 + col] = (u16)f2bf(v); }
        if (part == 0 && tid < 64) LAM[g * 64 + tid] = LP[16 * 64 + tid];
    }
    __syncthreads();
}

template <int MODE> __device__ __forceinline__ void row_pass(const Frame& F, const Args& a, int l) {
    float* wfx = (float*)(F.lds + 131072 - 32768);
    const float* g = nullptr; const float* bb = nullptr;
    if (MODE == 1) { g = a.in[18] + l * 1024; bb = a.in[19] + l * 1024; }
    if (MODE >= 2) { g = a.in[23] + l * 1024; bb = a.in[24] + l * 1024; }
    if (MODE == 0 || MODE == 2) {
        const float* win = a.in[1] + (size_t)(MODE == 0 ? 0 : l + 1) * DMOD * INTOT + 3584;
        __syncthreads();
        for (int e = F_TID; e < 8192; e += 512) { const int k = e >> 3, j = e & 7; wfx[j * 1024 + k] = win[(size_t)k * INTOT + j]; }
        __syncthreads();
    }
    const float* src = (MODE == 0) ? a.in[0] : (const float*)(F.ws + WS_PRE);
    const int gw = F.vcu * 8 + F_WAVE, NGW = F.G * 8;
    for (int m = gw; m < M; m += NGW) {
        const f32x4* xr = (const f32x4*)(src + (size_t)m * 1024) + F_LANE;
        f32x4 v[4];
#pragma unroll
        for (int j = 0; j < 4; ++j) v[j] = xr[64 * j];
        if (MODE != 0) {
            float s = 0.f;
#pragma unroll
            for (int j = 0; j < 4; ++j) s += (v[j].x + v[j].y) + (v[j].z + v[j].w);
            const float mean = wave_sum(s) * (1.f / 1024.f); float s2 = 0.f;
#pragma unroll
            for (int j = 0; j < 4; ++j) { v[j] = v[j] - mean; s2 += (v[j].x * v[j].x + v[j].y * v[j].y) + (v[j].z * v[j].z + v[j].w * v[j].w); }
            const float rstd = 1.f / sqrtf(wave_sum(s2) * (1.f / 1024.f) + LN_EPS);
#pragma unroll
            for (int j = 0; j < 4; ++j) { const f32x4 gg = ((const f32x4*)g)[64 * j + F_LANE], bv = ((const f32x4*)bb)[64 * j + F_LANE]; v[j] = v[j] * rstd * gg + bv; }
        }
        if (MODE == 1) {
            f32x4* o = (f32x4*)(F.ws + WS_PRE + (size_t)m * 4096) + F_LANE;
#pragma unroll
            for (int j = 0; j < 4; ++j) o[64 * j] = v[j];
            v2u* ob = (v2u*)(F.ws + WS_H1B + (size_t)m * 2048) + F_LANE;
#pragma unroll
            for (int j = 0; j < 4; ++j) { v2u w; w.x = pk2(v[j].x, v[j].y); w.y = pk2(v[j].z, v[j].w); ob[64 * j] = w; }
        } else if (MODE == 3) {
            f32x4* o = (f32x4*)(a.out + (size_t)m * 1024) + F_LANE;
#pragma unroll
            for (int j = 0; j < 4; ++j) o[64 * j] = v[j];
        } else {
            v2u* ob = (v2u*)(F.ws + WS_HB + (size_t)m * 2048) + F_LANE;
            v2u* ol = (v2u*)(F.ws + WS_HBL + (size_t)m * 2048) + F_LANE;
#pragma unroll
            for (int j = 0; j < 4; ++j) { v2u w; w.x = pk2(v[j].x, v[j].y); w.y = pk2(v[j].z, v[j].w); ob[64 * j] = w;
                if (MODE == 2) { v2u wl; wl.x = pk2(v[j].x - bflo(w.x), v[j].y - bfhi(w.x)); wl.y = pk2(v[j].z - bflo(w.y), v[j].w - bfhi(w.y)); ol[64 * j] = wl; } }
            float mine = 0.f;
#pragma unroll 1
            for (int c = 0; c < 8; ++c) { float s = 0.f;
#pragma unroll
                for (int j = 0; j < 4; ++j) { const f32x4 w = *(const f32x4*)(wfx + c * 1024 + 256 * j + 4 * F_LANE); s += (v[j].x * w.x + v[j].y * w.y) + (v[j].z * w.z + v[j].w * w.w); }
                s = wave_sum(s); if (F_LANE == c) mine = s; }
            if (F_LANE < 8) ((float*)(F.ws + WS_MISC + MISC_FXF))[(size_t)m * 8 + F_LANE] = mine;
        }
    }
}

template <int MT, int NT> __device__ __forceinline__ void mma_lds(f32x4 (&acc)[MT][NT], const u16* sA, int lda, const u16* sB, int ldb, int K, int lane) {
    const int r = lane & 15, q = lane >> 4;
    for (int k0 = 0; k0 < K; k0 += 32) {
        bf16x8 av[MT], bv[NT];
#pragma unroll
        for (int mt = 0; mt < MT; ++mt) av[mt] = *(const bf16x8*)(sA + (mt * 16 + r) * lda + k0 + q * 8);
#pragma unroll
        for (int nt = 0; nt < NT; ++nt) bv[nt] = *(const bf16x8*)(sB + (nt * 16 + r) * ldb + k0 + q * 8);
#pragma unroll
        for (int mt = 0; mt < MT; ++mt)
#pragma unroll
            for (int nt = 0; nt < NT; ++nt) acc[mt][nt] = __builtin_amdgcn_mfma_f32_16x16x32_bf16(av[mt], bv[nt], acc[mt][nt], 0, 0, 0);
    }
}

__device__ __forceinline__ void hgrn_issue_zf(const float* ZF, int row0, int h, int tid, f32x4 (&zf)[4]) {
#pragma unroll
    for (int i = 0; i < 4; ++i) { const int idx = tid + 512 * i, t = idx >> 5, k4 = (idx & 31) * 4; zf[i] = *(const f32x4*)(ZF + (size_t)(row0 + t) * 512 + h * 128 + k4); }
}
__device__ __forceinline__ void hgrn_issue_tile(const u16* Z, int row0, int h, int tid, v4u (&vt)[2]) {
#pragma unroll
    for (int i = 0; i < 2; ++i) { const int idx = tid + 512 * i, s_ = idx & 63, v8 = (idx >> 6) * 8; vt[i] = *(const v4u*)(Z + (size_t)(row0 + s_) * 512 + h * 128 + v8); }
}
__device__ __forceinline__ void hgrn_scan_lds(const f32x4 (&zf)[4], float* LG, float* KK, float* QT, int tid) {
#pragma unroll
    for (int i = 0; i < 4; ++i) { const int idx = tid + 512 * i, t = idx >> 5, k4 = (idx & 31) * 4; const f32x4 lf = zf[i];
        *(f32x4*)(LG + t * 128 + k4) = lf;
        f32x4 kk; kk[0] = 1.f - __expf(lf[0]); kk[1] = 1.f - __expf(lf[1]); kk[2] = 1.f - __expf(lf[2]); kk[3] = 1.f - __expf(lf[3]);
        *(f32x4*)(KK + t * 128 + k4) = kk; }
    __syncthreads();
    const int k = tid & 127, q = tid >> 7; float run = 0.f;
    for (int t = 16 * q; t < 16 * q + 16; ++t) { run += LG[t * 128 + k]; LG[t * 128 + k] = run; }
    QT[q * 128 + k] = run;
    __syncthreads();
}
__device__ __forceinline__ void store_vT(const v4u (&vt)[2], u16* BT, int tid) {
#pragma unroll
    for (int i = 0; i < 2; ++i) { const int idx = tid + 512 * i, s = idx & 63, v8 = (idx >> 6) * 8; const v4u e = vt[i];
        BT[(v8 + 0) * 72 + s] = (u16)(e.x & 0xffff); BT[(v8 + 1) * 72 + s] = (u16)(e.x >> 16); BT[(v8 + 2) * 72 + s] = (u16)(e.y & 0xffff); BT[(v8 + 3) * 72 + s] = (u16)(e.y >> 16);
        BT[(v8 + 4) * 72 + s] = (u16)(e.z & 0xffff); BT[(v8 + 5) * 72 + s] = (u16)(e.z >> 16); BT[(v8 + 6) * 72 + s] = (u16)(e.w & 0xffff); BT[(v8 + 7) * 72 + s] = (u16)(e.w >> 16); }
}
__device__ __forceinline__ void hgrn_a_unit(const Frame& F, int u) {
    const int b = u >> 7, h = (u >> 5) & 3, c = u & 31, row0 = b * SEQL + c * 64, tid = F_TID, lane = tid & 63, w = __builtin_amdgcn_readfirstlane(tid >> 6);
    float* LG = (float*)F.lds; float* KK = (float*)(F.lds + 32768); float* QT = (float*)(F.lds + 65536);
    u16* AT = (u16*)(F.lds + 67584); u16* BT = (u16*)(F.lds + 67584 + 18432);
    f32x4 zf[4]; v4u vt[2];
    hgrn_issue_zf((const float*)(F.ws + WS_ZF), row0, h, tid, zf);
    hgrn_issue_tile((const u16*)(F.ws + WS_ZI), row0, h, tid, vt);
    hgrn_scan_lds(zf, LG, KK, QT, tid);
    store_vT(vt, BT, tid);
    { const int k = tid & 127, q = tid >> 7; float off = 0.f, glast = 0.f;
#pragma unroll
      for (int qq = 0; qq < 4; ++qq) { const float t_ = QT[qq * 128 + k]; glast += t_; if (qq < q) off += t_; }
      for (int s = 16 * q; s < 16 * q + 16; ++s) { const float gg = LG[s * 128 + k] + off; AT[k * 72 + s] = (u16)f2bf(KK[s * 128 + k] * __expf(glast - gg)); }
      if (q == 0) ((float*)(F.ws + WS_MISC + MISC_DEC))[u * 128 + k] = __expf(glast); }
    __syncthreads();
    f32x4 acc[2][4];
#pragma unroll
    for (int i = 0; i < 2; ++i)
#pragma unroll
        for (int j = 0; j < 4; ++j) acc[i][j] = (f32x4){0.f, 0.f, 0.f, 0.f};
    mma_lds<2, 4>(acc, AT + ((w >> 1) * 32) * 72, 72, BT + ((w & 1) * 64) * 72, 72, 64, lane);
    u16* KV = (u16*)(F.ws + WS_KV) + (size_t)u * 16384;
#pragma unroll
    for (int mt = 0; mt < 2; ++mt)
#pragma unroll
        for (int nt = 0; nt < 4; ++nt) { const int k0 = (w >> 1) * 32 + mt * 16 + (lane >> 4) * 4, v = (w & 1) * 64 + nt * 16 + (lane & 15);
            v2u o; o.x = pk2(acc[mt][nt][0], acc[mt][nt][1]); o.y = pk2(acc[mt][nt][2], acc[mt][nt][3]); *(v2u*)(KV + v * 128 + k0) = o; }
    __syncthreads();
}
__device__ __forceinline__ void hgrn_scan(const Frame& F) {
    const float* DEC = (const float*)(F.ws + WS_MISC + MISC_DEC);
    for (int gid = blockIdx.x * 512 + F_TID; gid < 32 * 4096; gid += F.G * 512) {
        const int bh = gid >> 12, e = (gid & 4095) * 4, k = e & 127;
        float s0 = 0.f, s1 = 0.f, s2 = 0.f, s3 = 0.f;
        u16* p = (u16*)(F.ws + WS_KV) + (size_t)bh * 32 * 16384 + e;
        const float* dp = DEC + (size_t)bh * 32 * 128 + k;
#pragma unroll 4
        for (int c = 0; c < 32; ++c) { const v2u kv = *(const v2u*)(p + (size_t)c * 16384); const f32x4 d = *(const f32x4*)(dp + c * 128);
            v2u o; o.x = pk2(s0, s1); o.y = pk2(s2, s3); *(v2u*)(p + (size_t)c * 16384) = o;
            s0 = d[0] * s0 + bflo(kv.x); s1 = d[1] * s1 + bfhi(kv.x); s2 = d[2] * s2 + bflo(kv.y); s3 = d[3] * s3 + bfhi(kv.y); }
    }
}
__device__ __forceinline__ void hgrn_c_unit(const Frame& F, const Args& a, int l, int u) {
    const int b = u >> 7, h = (u >> 5) & 3, c = u & 31, row0 = b * SEQL + c * 64, tid = F_TID, lane = tid & 63, w = __builtin_amdgcn_readfirstlane(tid >> 6);
    float* LG = (float*)F.lds; float* KK = (float*)(F.lds + 32768); float* QT = (float*)(F.lds + 65536);
    u16* ST = (u16*)F.lds; u16* BT = (u16*)(F.lds + 34816); u16* PP = (u16*)(F.lds + 53248);
    u16* QE = (u16*)(F.lds + 67584); u16* KE = (u16*)(F.lds + 84992); float* RS = (float*)(F.lds + 102400);
    u16* QR = (u16*)(F.lds + 102912); u16* GT = (u16*)(F.lds + 102912 + 17408);
    f32x4 zf[4]; v4u vt[2], qt[2], gt[2], st[4];
    hgrn_issue_zf((const float*)(F.ws + WS_ZF), row0, h, tid, zf);
    hgrn_issue_tile((const u16*)(F.ws + WS_ZQ), row0, h, tid, qt);
    { const u16* KV = (const u16*)(F.ws + WS_KV) + (size_t)u * 16384;
#pragma unroll
      for (int i = 0; i < 4; ++i) { const int idx = tid + 512 * i, v = idx >> 4, k8 = (idx & 15) * 8; st[i] = *(const v4u*)(KV + v * 128 + k8); } }
    hgrn_issue_tile((const u16*)(F.ws + WS_ZI), row0, h, tid, vt);
    hgrn_issue_tile((const u16*)(F.ws + WS_ZG), row0, h, tid, gt);
#pragma unroll
    for (int i = 0; i < 2; ++i) { const int idx = tid + 512 * i, s_ = idx & 63, c8 = (idx >> 6) * 8; *(v4u*)(QR + s_ * 136 + c8) = qt[i]; }
    hgrn_scan_lds(zf, LG, KK, QT, tid);
    { const int k = tid & 127, q = tid >> 7; float off = 0.f;
#pragma unroll
      for (int qq = 0; qq < 4; ++qq) { const float t_ = QT[qq * 128 + k]; if (qq < q) off += t_; }
      for (int t = 16 * q; t < 16 * q + 16; ++t) { const float gg = LG[t * 128 + k] + off; const float qv = bf2f(QR[t * 136 + k]);
          QE[t * 136 + k] = (u16)f2bf(qv * __expf(gg)); KE[t * 136 + k] = (u16)f2bf(KK[t * 128 + k] * __expf(fminf(-gg, 80.f))); } }
    __syncthreads();
#pragma unroll
    for (int i = 0; i < 4; ++i) { const int idx = tid + 512 * i, v = idx >> 4, k8 = (idx & 15) * 8; *(v4u*)(ST + v * 136 + k8) = st[i]; }
    store_vT(vt, BT, tid);
#pragma unroll
    for (int i = 0; i < 2; ++i) { const int idx = tid + 512 * i, s_ = idx & 63, c8 = (idx >> 6) * 8; *(v4u*)(GT + s_ * 136 + c8) = gt[i]; }
    const int mt = w >> 1;
    { f32x4 sc[1][2]; sc[0][0] = (f32x4){0.f, 0.f, 0.f, 0.f}; sc[0][1] = (f32x4){0.f, 0.f, 0.f, 0.f};
      const int nt0 = (w & 1) * 2;
      mma_lds<1, 2>(sc, QE + mt * 16 * 136, 136, KE + nt0 * 16 * 136, 136, 128, lane);
#pragma unroll
      for (int i = 0; i < 2; ++i)
#pragma unroll
          for (int j = 0; j < 4; ++j) { const int t = mt * 16 + (lane >> 4) * 4 + j, s_ = (nt0 + i) * 16 + (lane & 15); PP[t * 72 + s_] = (u16)f2bf(s_ <= t ? sc[0][i][j] : 0.f); } }
    __syncthreads();
    f32x4 acc[1][4];
#pragma unroll
    for (int i = 0; i < 4; ++i) acc[0][i] = (f32x4){0.f, 0.f, 0.f, 0.f};
    mma_lds<1, 4>(acc, QE + mt * 16 * 136, 136, ST + ((w & 1) * 64) * 136, 136, 128, lane);
    mma_lds<1, 4>(acc, PP + mt * 16 * 72, 72, BT + ((w & 1) * 64) * 72, 72, 64, lane);
#pragma unroll
    for (int j = 0; j < 4; ++j) { float ss = 0.f;
#pragma unroll
        for (int i = 0; i < 4; ++i) ss += acc[0][i][j] * acc[0][i][j];
        ss += __shfl_xor(ss, 1); ss += __shfl_xor(ss, 2); ss += __shfl_xor(ss, 4); ss += __shfl_xor(ss, 8);
        if ((lane & 15) == 0) RS[(mt * 16 + (lane >> 4) * 4 + j) * 2 + (w & 1)] = ss; }
    __syncthreads();
    const float* nw = a.in[3] + l * 128;
#pragma unroll
    for (int j = 0; j < 4; ++j) { const int t = mt * 16 + (lane >> 4) * 4 + j; const float r = rsqrtf((RS[t * 2] + RS[t * 2 + 1]) * (1.f / 128.f) + RMS_EPS);
        const size_t ro = (size_t)(row0 + t) * 512 + h * 128;
#pragma unroll
        for (int i = 0; i < 4; ++i) { const int v = (w & 1) * 64 + i * 16 + (lane & 15); const float gv = bf2f(GT[t * 136 + v]);
            ((u16*)(F.ws + WS_YA))[ro + v] = (u16)f2bf(acc[0][i][j] * r * nw[v] * gv * sigm(gv)); } }
    __syncthreads();
}

__device__ __forceinline__ void load_tile16(u16* dst, int dpitch, const u16* src, size_t spitch, int rows, int cols8, int tid) {
    for (int idx = tid; idx < rows * cols8; idx += 512) { const int r = idx / cols8, c8 = idx - r * cols8; *(v4u*)(dst + r * dpitch + c8 * 8) = *(const v4u*)(src + (size_t)r * spitch + c8 * 8); }
}
__device__ __forceinline__ void s5_1_unit(const Frame& F, int unit) {
    const int g = unit >> 3, rt = unit & 7, tid = F_TID, lane = F_LANE, w = F_WAVE;
    u16* A = (u16*)F.lds; u16* B = (u16*)(F.lds + 67584);
    load_tile16(A, 264, (const u16*)(F.ws + WS_SU) + ((size_t)g * 1024 + rt * 128) * 256, 256, 128, 32, tid);
    load_tile16(B, 264, (const u16*)(F.dout + DO_EM) + (size_t)g * 128 * 256, 256, 128, 32, tid);
    __syncthreads();
    f32x4 acc[2][4];
#pragma unroll
    for (int i = 0; i < 2; ++i)
#pragma unroll
        for (int j = 0; j < 4; ++j) acc[i][j] = (f32x4){0.f, 0.f, 0.f, 0.f};
    mma_lds<2, 4>(acc, A + ((w >> 1) * 32) * 264, 264, B + ((w & 1) * 64) * 264, 264, 256, lane);
    u16* SE = (u16*)(F.ws + WS_SE);
#pragma unroll
    for (int mt = 0; mt < 2; ++mt)
#pragma unroll
        for (int nt = 0; nt < 4; ++nt)
#pragma unroll
            for (int j = 0; j < 4; ++j) { const int n = rt * 128 + (w >> 1) * 32 + mt * 16 + (lane >> 4) * 4 + j, r = (w & 1) * 64 + nt * 16 + (lane & 15);
                SE[((size_t)n * 32 + g) * 128 + r] = (u16)f2bf(acc[mt][nt][j]); }
    __syncthreads();
}
__device__ __forceinline__ void s5_scan(const Frame& F) {
    const float2* LAM = (const float2*)(F.dout + DO_LAM);
    float2* XL = (float2*)F.lds;
    const int tid = F_TID, seg = __builtin_amdgcn_readfirstlane(tid >> 6), p = tid & 63;
    for (int pair = blockIdx.x; pair < 256; pair += F.G) {
        const int b = pair >> 5, g = pair & 31; const float2 lm = LAM[g * 64 + p];
        u16* base = (u16*)(F.ws + WS_SE) + ((size_t)(b * 128 + seg * 16) * 32 + g) * 128 + p;
        float er[16], ei[16];
#pragma unroll
        for (int i = 0; i < 16; ++i) { const u16* q = base + (size_t)i * 4096; er[i] = bf2f(q[0]); ei[i] = bf2f(q[64]); }
        float sr = 0.f, si = 0.f;
#pragma unroll
        for (int i = 0; i < 16; ++i) { const float nr = lm.x * sr - lm.y * si + er[i], ni = lm.x * si + lm.y * sr + ei[i]; er[i] = sr; ei[i] = si; sr = nr; si = ni; }
        XL[seg * 64 + p] = make_float2(sr, si);
        float pr = lm.x, pi = lm.y;
#pragma unroll
        for (int k = 0; k < 4; ++k) { const float nr = pr * pr - pi * pi, ni = 2.f * pr * pi; pr = nr; pi = ni; }
        __syncthreads();
        float ar = 0.f, ai = 0.f;
        for (int s2 = 0; s2 < seg; ++s2) { const float2 t = XL[s2 * 64 + p]; const float nr = pr * ar - pi * ai + t.x, ni = pr * ai + pi * ar + t.y; ar = nr; ai = ni; }
        float wr_ = 1.f, wi_ = 0.f;
#pragma unroll
        for (int i = 0; i < 16; ++i) { u16* q = base + (size_t)i * 4096; q[0] = (u16)f2bf(wr_ * ar - wi_ * ai + er[i]); q[64] = (u16)f2bf(wr_ * ai + wi_ * ar + ei[i]);
            const float nr = wr_ * lm.x - wi_ * lm.y, ni = wr_ * lm.y + wi_ * lm.x; wr_ = nr; wi_ = ni; }
        __syncthreads();
    }
}
__device__ __forceinline__ void s5_2_issue(const Frame& F, int g, int rt, int kc, int tid, v4u (&ra)[4], v4u (&rb)[8]) {
    const u16* srcA; size_t pa;
    if (kc < 2) { srcA = (const u16*)(F.ws + WS_SU) + ((size_t)g * 1024 + rt * 128) * 256 + kc * 128; pa = 256; }
    else        { srcA = (const u16*)(F.ws + WS_SE) + ((size_t)(rt * 128) * 32 + g) * 128; pa = 4096; }
    const u16* srcB = (const u16*)(F.dout + DO_TM) + (size_t)g * 256 * 384 + kc * 128;
#pragma unroll
    for (int i = 0; i < 4; ++i) { const int idx = tid + 512 * i, r = idx >> 4, c8 = idx & 15; ra[i] = *(const v4u*)(srcA + (size_t)r * pa + c8 * 8); }
#pragma unroll
    for (int i = 0; i < 8; ++i) { const int idx = tid + 512 * i, r = idx >> 4, c8 = idx & 15; rb[i] = *(const v4u*)(srcB + (size_t)r * 384 + c8 * 8); }
}
__device__ __forceinline__ void s5_2_unit(const Frame& F, int unit) {
    const int g = unit >> 3, rt = unit & 7, tid = F_TID, lane = tid & 63, w = __builtin_amdgcn_readfirstlane(tid >> 6);
    u16* A = (u16*)F.lds; u16* B = (u16*)(F.lds + 34816);
    f32x4 acc[2][8];
#pragma unroll
    for (int i = 0; i < 2; ++i)
#pragma unroll
        for (int j = 0; j < 8; ++j) acc[i][j] = (f32x4){0.f, 0.f, 0.f, 0.f};
    v4u ra[4], rb[8];
    s5_2_issue(F, g, rt, 0, tid, ra, rb);
    for (int kc = 0; kc < 3; ++kc) {
        __syncthreads();
#pragma unroll
        for (int i = 0; i < 4; ++i) { const int idx = tid + 512 * i, r = idx >> 4, c8 = idx & 15; *(v4u*)(A + r * 136 + c8 * 8) = ra[i]; }
#pragma unroll
        for (int i = 0; i < 8; ++i) { const int idx = tid + 512 * i, r = idx >> 4, c8 = idx & 15; *(v4u*)(B + r * 136 + c8 * 8) = rb[i]; }
        if (kc < 2) s5_2_issue(F, g, rt, kc + 1, tid, ra, rb);
        __syncthreads();
        mma_lds<2, 8>(acc, A + ((w >> 1) * 32) * 136, 136, B + ((w & 1) * 128) * 136, 136, 128, lane);
    }
    u16* YG = (u16*)(F.dout + DO_YG);
#pragma unroll
    for (int mt = 0; mt < 2; ++mt)
#pragma unroll
        for (int nt = 0; nt < 8; ++nt)
#pragma unroll
            for (int j = 0; j < 4; ++j) { const int n = rt * 128 + (w >> 1) * 32 + mt * 16 + (lane >> 4) * 4 + j, i = (w & 1) * 8 + nt, hp = lane & 15;
                const float y = acc[mt][nt][j]; const float z = 0.7978845608028654f * (y + 0.044715f * y * y * y);
                const float th = 1.f - 2.f / (__expf(2.f * z) + 1.f);
                YG[((size_t)n * 16 + i) * 512 + 16 * g + hp] = (u16)f2bf(0.5f * y * (1.f + th)); }
    __syncthreads();
}

#ifndef REP_MIX
#define REP_MIX 1
#endif
#ifndef REP_SYNC
#define REP_SYNC 1
#endif
#ifndef REP_G1
#define REP_G1 1
#endif
#define GSYNC() do { for (int rs_ = 0; rs_ < REP_SYNC; ++rs_) xcd_barrier(xbar); } while (0)
__global__ void __launch_bounds__(512, 2) mega_fwd(Args a) {
    extern __shared__ __attribute__((aligned(16))) unsigned char lds[];
    cg::grid_group grid = cg::this_grid();
    Frame F; F.lds = lds; F.ws = a.ws; F.dout = (unsigned char*)a.out;
    F.G = gridDim.x; { const int bx = blockIdx.x; F.vcu = (F.G % 8 == 0) ? (bx % 8) * (F.G / 8) + bx / 8 : bx; }
    PG8_LAS unsigned char* glds = (PG8_LAS unsigned char*)lds;
    typedef pg8::bf16_t pb;
    unsigned char* ws = a.ws; unsigned char* dq = F.dout;

    unsigned* barw = (unsigned*)(ws + WS_MISC + 3 * MiB);
    volatile LAS unsigned* xst = (volatile LAS unsigned*)((LAS unsigned char*)lds + 147392);
    if (threadIdx.x < 16) xst[threadIdx.x] = 0u;
    if (blockIdx.x == 0) for (int i = threadIdx.x; i < XCD_BAR_WORDS; i += 512) barw[i] = 0u;
    if (blockIdx.x == 0) { float* LB = (float*)(ws + WS_MISC + MISC_LB);
        for (int k = F_TID; k < 512; k += 512) { const float a0 = a.in[2][k], a1 = a.in[2][512 + k], mx = fmaxf(a0, a1), e0 = expf(a0 - mx), e1 = expf(a1 - mx); LB[k] = 0.f; LB[512 + k] = e1 / (e0 + e1); } }
#ifndef NO_PRO
#ifdef REP_CVT
    convert_weights(F, a, 0);
    s5_mats(F, a, 0);
#endif
    convert_weights(F, a, 0);
    s5_mats(F, a, 0);
#endif
#ifndef NO_ROW
    row_pass<0>(F, a, 0);
#endif
    grid.sync();
    const XcdBarrier xbar = xcd_barrier_post(barw, xst);

    for (int l = 0; l < 2; ++l) {
#ifndef NO_GEMM
        { pg8::Gemm g{(const pb*)(ws + WS_HB), (const pb*)(dq + DO_WIN), M, 4096, 1024}; pg8::StaticOrder S; S.init(M, 4096, F.G, (int)blockIdx.x);
          pg8::EpiIn E{ws, (const float*)(ws + WS_MISC + MISC_LB) + l * 512, attn_body::C2};
          for (int rep_ = 0; rep_ < REP_G1; ++rep_) pg8::gemm_phase<pg8::EpiIn, pg8::StaticOrder, true, true>(glds, g, S, E); }
#endif
        GSYNC();
#ifndef NO_ATTN
        { const attn_body::AttnTensors AT{(const attn_body::bf16*)(ws + WS_FQ), (const attn_body::bf16*)(ws + WS_FK), (const attn_body::bf16*)(ws + WS_FV), (attn_body::bf16*)(ws + WS_YB),
                                          (const float*)(ws + WS_MISC + MISC_FXF), a.in[4] + l * 8};
          const attn_body::StaticOrder S((int)F.G, (int)blockIdx.x);
#ifdef REP_ATTN
          { const attn_body::AttnTensors AT2{(const attn_body::bf16*)(ws + WS_FQ), (const attn_body::bf16*)(ws + WS_FK), (const attn_body::bf16*)(ws + WS_FV), (attn_body::bf16*)(dq + DO_YG),
                                          (const float*)(ws + WS_MISC + MISC_FXF), a.in[4] + l * 8};
            attn_body::attn_phase<attn_body::StaticOrder>((char*)lds, AT2, S); }
#endif
          attn_body::attn_phase<attn_body::StaticOrder>((char*)lds, AT, S); }
#endif
        __syncthreads();
#ifndef NO_MIX
        for (int rep_ = 0; rep_ < REP_MIX; ++rep_) {
        for (int u = F.vcu; u < 1024; u += F.G) hgrn_a_unit(F, u);
        for (int u = F.vcu; u < 256; u += F.G) s5_1_unit(F, u);
        }
#endif
        GSYNC();
#ifndef NO_MIX
        hgrn_scan(F);
        s5_scan(F);
#endif
        GSYNC();
#ifndef NO_MIX
        for (int rep_ = 0; rep_ < REP_MIX; ++rep_) {
        for (int u = F.vcu; u < 1024; u += F.G) hgrn_c_unit(F, a, l, u);
        for (int u = F.vcu; u < 256; u += F.G) s5_2_unit(F, u);
        }
#endif
        GSYNC();
#ifndef NO_GEMM2
        { pg8::Gemm g{(const pb*)(dq + DO_YG), (const pb*)(dq + DO_WGLU), M, 512, 512}; pg8::StaticOrder S; S.init(M, 512, F.G, (int)blockIdx.x);
          pg8::EpiGlu E{(const pb*)(dq + DO_YG), (pb*)(ws + WS_YC)};
          pg8::gemm_phase<pg8::EpiGlu, pg8::StaticOrder, true, true>(glds, g, S, E); }
        { pg8::Gemm g{(const pb*)(ws + WS_HB), (const pb*)(dq + DO_WIN) + (size_t)4096 * 1024, M, 3072, 1024}; pg8::StaticOrder S; S.init(M, 3072, F.G, (int)blockIdx.x);
          pg8::EpiGate E{(pb*)(ws + WS_GATES)};
          pg8::gemm_phase<pg8::EpiGate, pg8::StaticOrder, true, true>(glds, g, S, E); }
        GSYNC();
        { pg8::Gemm g{(const pb*)(ws + WS_YA), (const pb*)(dq + DO_WBR), 3 * M, 3072, 512}; pg8::BranchOrder S; S.init(F.G, (int)blockIdx.x);
          pg8::EpiBranch E{(const pb*)(ws + WS_GATES), (pb*)(ws + WS_MERGED)};
          pg8::gemm_phase<pg8::EpiBranch, pg8::BranchOrder, true, true>(glds, g, S, E); }
        GSYNC();
        { pg8::Gemm g{(const pb*)(ws + WS_MERGED), (const pb*)(dq + DO_WOUT), M, 1024, 1024}; pg8::StaticOrder S; S.init(M, 1024, F.G, (int)blockIdx.x);
          pg8::EpiRes E{l == 0 ? a.in[0] : nullptr, (const pb*)(ws + WS_HB), (const pb*)(ws + WS_HBL), (float*)(ws + WS_PRE)};
          pg8::gemm_phase<pg8::EpiRes, pg8::StaticOrder, true, true>(glds, g, S, E); }
        GSYNC();
#endif
#ifndef NO_ROW
        row_pass<1>(F, a, l);
#endif
        GSYNC();
#ifndef NO_GEMM3
        { pg8::Gemm g{(const pb*)(ws + WS_H1B), (const pb*)(dq + DO_WGU), M, 5632, 1024}; pg8::StaticOrder S; S.init(M, 5632, F.G, (int)blockIdx.x);
          pg8::EpiSwiglu E{(pb*)(ws + WS_FFH)};
          for (int rep_ = 0; rep_ < REP_G1; ++rep_) pg8::gemm_phase<pg8::EpiSwiglu, pg8::StaticOrder, true, true>(glds, g, S, E); }
        GSYNC();
        { pg8::Gemm g{(const pb*)(ws + WS_FFH), (const pb*)(dq + DO_WDN), M, 1024, FFN_H}; pg8::StaticOrder S; S.init(M, 1024, F.G, (int)blockIdx.x);
          pg8::EpiRes E{(const float*)(ws + WS_PRE), nullptr, nullptr, (float*)(ws + WS_PRE)};
          pg8::gemm_phase<pg8::EpiRes, pg8::StaticOrder, true, true>(glds, g, S, E); }
        GSYNC();
#endif
        if (l == 0) {
#ifndef NO_PRO
#ifdef REP_CVT
            convert_weights(F, a, 1); s5_mats(F, a, 1);
#endif
            convert_weights(F, a, 1); s5_mats(F, a, 1);
#endif
#ifndef NO_ROW
            row_pass<2>(F, a, 0);
#endif
            GSYNC(); }
#ifndef NO_ROW
        else row_pass<3>(F, a, 1);
#endif
    }
}

extern "C" void kernel_launch(void* const* d_in, const int* in_sizes, int n_in, void* d_out, int out_size, void* d_ws, size_t ws_size, hipStream_t stream) {
    static int grid = 0;
    if (grid == 0) {
        int dev = 0, cus = 0, per_cu = 0;
        if (hipGetDevice(&dev) != hipSuccess || hipDeviceGetAttribute(&cus, hipDeviceAttributeMultiprocessorCount, dev) != hipSuccess) { fprintf(stderr, "kernel_launch: device query failed\n"); grid = -1; return; }
        if (hipFuncSetAttribute((const void*)mega_fwd, hipFuncAttributeMaxDynamicSharedMemorySize, LDS_BYTES) != hipSuccess) { fprintf(stderr, "kernel_launch: hipFuncSetAttribute failed\n"); grid = -1; return; }
        if (hipOccupancyMaxActiveBlocksPerMultiprocessor(&per_cu, (const void*)mega_fwd, 512, LDS_BYTES) != hipSuccess || per_cu < 1) { fprintf(stderr, "kernel_launch: occupancy query says %d blocks per CU\n", per_cu); grid = -1; return; }
        grid = cus;
        if (n_in != 25 || out_size != M * DMOD || ws_size < 256 * MiB) { fprintf(stderr, "kernel_launch: unexpected shapes (n_in %d out %d ws %zu)\n", n_in, out_size, ws_size); grid = -1; return; }
    }
    if (grid < 0) return;
    Args a{};
    for (int i = 0; i < 25; ++i) a.in[i] = (const float*)d_in[i];
    a.out = (float*)d_out; a.ws = (unsigned char*)d_ws;
    void* args[] = {&a};
    hipError_t e = hipLaunchCooperativeKernel((void*)mega_fwd, dim3(grid), dim3(512), args, LDS_BYTES, stream);
    if (e != hipSuccess) fprintf(stderr, "kernel_launch: cooperative launch failed: %s (grid %d)\n", hipGetErrorString(e), grid);
}
```
